# Optimizing an MI355X kernel written in HIP

```python
import math
import jax, jax.numpy as jnp
from jax import lax
import numpy as np

D_MODEL = 1024
BATCH = 4
SEQ = 4096
DEPTH = 1

CHUNK = 64
Q_BLOCK = 128
N_MEM = 256
EPS = 1e-6
NEG_INF = -1e30

D_MIX = D_MODEL
D_SSM = D_MIX // 2
SSM_GROUP = 16
SSM_GROUPS = D_SSM // SSM_GROUP
SSM_STATE = 64
DT_MIN = 1e-3
DT_MAX = 1e-1
D_MLA = D_MIX - D_SSM
MLA_HEADS = 8
MLA_NOPE = 64
MLA_ROPE = 32
MLA_QK = MLA_NOPE + MLA_ROPE
MLA_V = D_MLA // MLA_HEADS
MLA_Q_RANK = 768
MLA_KV_RANK = 256
ROPE_THETA = 10000.0
D_IN = D_SSM + MLA_Q_RANK + MLA_KV_RANK + MLA_ROPE
XATTN_HEADS = 4
XATTN_HEAD_DIM = D_MODEL // XATTN_HEADS
MOE_GROUPS = 4
MOE_PER_GROUP = 8
MOE_EXPERTS = MOE_GROUPS * MOE_PER_GROUP
MOE_TOPK = 2
MOE_FF = D_MODEL // 4

kernel_name = 'hybrid_s5_mla_hmoe_encoder'


def _rms(x, g):
    xf = x.astype(jnp.float32)
    y = xf * lax.rsqrt(jnp.mean(xf * xf, axis=-1, keepdims=True) + EPS)
    return (y * g.astype(jnp.float32)).astype(x.dtype)


def _rope(x, pos):
    half = MLA_ROPE // 2
    inv_freq = ROPE_THETA ** (-jnp.arange(half, dtype=jnp.float32) / half)
    ang = pos.astype(jnp.float32)[..., None] * inv_freq
    if x.ndim == 4:
        ang = ang[:, :, None, :]
    cos, sin = jnp.cos(ang), jnp.sin(ang)
    xf = x.astype(jnp.float32)
    x1, x2 = xf[..., :half], xf[..., half:]
    return jnp.concatenate([x1 * cos - x2 * sin, x1 * sin + x2 * cos], axis=-1).astype(x.dtype)


def _s5_mixer(u, lam_re, lam_im, log_dt, b_re, b_im, c_re, c_im, d_skip, w_glu, b_glu):
    bsz, seq, _ = u.shape
    uf = u.astype(jnp.float32).reshape(bsz, seq, SSM_GROUPS, SSM_GROUP)
    lam = lax.complex(jnp.minimum(lam_re.astype(jnp.float32), -1e-4), lam_im.astype(jnp.float32))
    dt = jnp.exp(log_dt.astype(jnp.float32))[:, None]
    a_bar = jnp.exp(lam * dt)
    b = lax.complex(b_re.astype(jnp.float32), b_im.astype(jnp.float32))
    b_bar = ((a_bar - 1.0) / lam)[..., None] * b
    c = lax.complex(c_re.astype(jnp.float32), c_im.astype(jnp.float32))
    bu = jnp.einsum('gph,bsgh->bsgp', b_bar, uf.astype(jnp.complex64))
    a_full = jnp.broadcast_to(a_bar, bu.shape)

    def combine(earlier, later):
        a_e, s_e = earlier
        a_l, s_l = later
        return a_l * a_e, a_l * s_e + s_l

    _, states = lax.associative_scan(combine, (a_full, bu), axis=1)
    y = jnp.einsum('ghp,bsgp->bsgh', c, states).real
    y = y + d_skip.astype(jnp.float32).reshape(SSM_GROUPS, SSM_GROUP) * uf
    y = jax.nn.gelu(y.reshape(bsz, seq, D_SSM))
    y = y * jax.nn.sigmoid(y @ w_glu.astype(jnp.float32) + b_glu.astype(jnp.float32))
    return y.astype(u.dtype)


def _mla_mixer(c_q, c_kv, k_rope, pos, q_norm_g, w_q_up, kv_norm_g, w_kv_up):
    bsz, seq, _ = c_q.shape
    q = (_rms(c_q, q_norm_g) @ w_q_up).reshape(bsz, seq, MLA_HEADS, MLA_QK)
    q = jnp.concatenate([q[..., :MLA_NOPE], _rope(q[..., MLA_NOPE:], pos)], axis=-1)
    kv = (_rms(c_kv, kv_norm_g) @ w_kv_up).reshape(bsz, seq, MLA_HEADS, MLA_NOPE + MLA_V)
    k_pe = _rope(k_rope, pos)
    k = jnp.concatenate(
        [kv[..., :MLA_NOPE], jnp.broadcast_to(k_pe[:, :, None, :], (bsz, seq, MLA_HEADS, MLA_ROPE))],
        axis=-1)
    v = kv[..., MLA_NOPE:]
    scale = MLA_QK ** -0.5
    n_blk = seq // Q_BLOCK
    q_blocks = q.reshape(bsz, n_blk, Q_BLOCK, MLA_HEADS, MLA_QK).transpose(1, 0, 2, 3, 4)
    key_chunk = jnp.arange(seq) // CHUNK

    def attend(args):
        blk, qb = args
        s = jnp.einsum('bqhd,bkhd->bhqk', qb, k).astype(jnp.float32) * scale
        q_chunk = (blk * Q_BLOCK + jnp.arange(Q_BLOCK)) // CHUNK
        mask = key_chunk[None, :] <= q_chunk[:, None]
        s = jnp.where(mask[None, None], s, NEG_INF)
        p = jax.nn.softmax(s, axis=-1).astype(v.dtype)
        return jnp.einsum('bhqk,bkhd->bqhd', p, v)

    o = lax.map(attend, (jnp.arange(n_blk), q_blocks))
    return o.transpose(1, 0, 2, 3, 4).reshape(bsz, seq, D_MLA)


def _memory_xattn(h, mem_n, w_q, w_k, w_v, w_o):
    bsz, seq, _ = h.shape
    n_mem = mem_n.shape[1]
    q = (h @ w_q).reshape(bsz, seq, XATTN_HEADS, XATTN_HEAD_DIM)
    k = (mem_n @ w_k).reshape(bsz, n_mem, XATTN_HEADS, XATTN_HEAD_DIM)
    v = (mem_n @ w_v).reshape(bsz, n_mem, XATTN_HEADS, XATTN_HEAD_DIM)
    s = jnp.einsum('bshd,bmhd->bhsm', q, k).astype(jnp.float32) * (XATTN_HEAD_DIM ** -0.5)
    p = jax.nn.softmax(s, axis=-1).astype(v.dtype)
    o = jnp.einsum('bhsm,bmhd->bshd', p, v).reshape(bsz, seq, D_MODEL)
    return o @ w_o


def _hier_moe(h, w_group, b_group, w_expert, b_expert, w_gate, w_up, w_down):
    bsz, seq, d = h.shape
    t = h.reshape(bsz * seq, d)
    g_prob = jax.nn.softmax((t @ w_group).astype(jnp.float32) + b_group.astype(jnp.float32), axis=-1)
    g_idx = jnp.argmax(g_prob, axis=-1)
    g_w = jnp.max(g_prob, axis=-1)
    g_onehot = jax.nn.one_hot(g_idx, MOE_GROUPS, dtype=jnp.float32)
    e_logits = jnp.einsum('td,dge->tge', t, w_expert).astype(jnp.float32) + b_expert.astype(jnp.float32)
    e_logits = jnp.sum(e_logits * g_onehot[:, :, None], axis=1)
    top_v, top_i = lax.top_k(e_logits, MOE_TOPK)
    top_w = jax.nn.softmax(top_v, axis=-1) * g_w[:, None]
    eid = g_idx[:, None] * MOE_PER_GROUP + top_i
    gates = jnp.sum(jax.nn.one_hot(eid, MOE_EXPERTS, dtype=jnp.float32) * top_w[..., None], axis=1)
    gates = gates.astype(t.dtype)
    out = jnp.zeros_like(t)
    for g in range(MOE_GROUPS):
        sl = slice(g * MOE_PER_GROUP, (g + 1) * MOE_PER_GROUP)
        a = jax.nn.silu(jnp.einsum('td,edf->tef', t, w_gate[sl])) * jnp.einsum('td,edf->tef', t, w_up[sl])
        a = a * gates[:, sl, None]
        out = out + jnp.einsum('tef,efd->td', a, w_down[sl])
    return out.reshape(bsz, seq, d)


def setup_inputs(seed: int = 0) -> dict:
    key = jax.random.key(seed)
    split = jax.random.split(key, 48)
    ks = iter([split[i] for i in range(48)])
    f32 = jnp.float32
    L = DEPTH

    def nrm(shape, scale):
        return jax.random.normal(next(ks), shape, f32) * scale

    def gain(n):
        return 1.0 + nrm((L, n), 0.02)

    x = nrm((BATCH, SEQ, D_MODEL), 1.0)
    mem = nrm((BATCH, N_MEM, D_MODEL), 1.0)
    offset = jax.random.randint(next(ks), (BATCH, 1), 0, 4096, dtype=jnp.int32)
    positions = offset + jnp.arange(SEQ, dtype=jnp.int32)[None, :]
    n_idx = jnp.arange(SSM_STATE, dtype=f32)
    return {
        'x': x,
        'mem': mem,
        'positions': positions,
        'norm_mix_g': gain(D_MODEL),
        'w_in': nrm((L, D_MODEL, D_IN), D_MODEL ** -0.5),
        'ssm_lam_re': -0.5 + nrm((L, SSM_GROUPS, SSM_STATE), 0.01),
        'ssm_lam_im': math.pi * n_idx + nrm((L, SSM_GROUPS, SSM_STATE), 0.01),
        'ssm_log_dt': jax.random.uniform(next(ks), (L, SSM_GROUPS), f32, math.log(DT_MIN), math.log(DT_MAX)),
        'ssm_b_re': nrm((L, SSM_GROUPS, SSM_STATE, SSM_GROUP), (2 * SSM_GROUP) ** -0.5),
        'ssm_b_im': nrm((L, SSM_GROUPS, SSM_STATE, SSM_GROUP), (2 * SSM_GROUP) ** -0.5),
        'ssm_c_re': nrm((L, SSM_GROUPS, SSM_GROUP, SSM_STATE), (2 * SSM_STATE) ** -0.5),
        'ssm_c_im': nrm((L, SSM_GROUPS, SSM_GROUP, SSM_STATE), (2 * SSM_STATE) ** -0.5),
        'ssm_d': nrm((L, D_SSM), 0.5),
        'ssm_w_glu': nrm((L, D_SSM, D_SSM), D_SSM ** -0.5),
        'ssm_b_glu': nrm((L, D_SSM), 0.01),
        'mla_q_norm_g': gain(MLA_Q_RANK),
        'mla_w_q_up': nrm((L, MLA_Q_RANK, MLA_HEADS * MLA_QK), MLA_Q_RANK ** -0.5),
        'mla_kv_norm_g': gain(MLA_KV_RANK),
        'mla_w_kv_up': nrm((L, MLA_KV_RANK, MLA_HEADS * (MLA_NOPE + MLA_V)), MLA_KV_RANK ** -0.5),
        'out_norm_ssm_g': gain(D_SSM),
        'out_norm_mla_g': gain(D_MLA),
        'w_out': nrm((L, D_MIX, D_MODEL), D_MIX ** -0.5),
        'norm_xattn_g': gain(D_MODEL),
        'norm_mem_g': gain(D_MODEL),
        'xattn_w_q': nrm((L, D_MODEL, D_MODEL), D_MODEL ** -0.5),
        'xattn_w_k': nrm((L, D_MODEL, D_MODEL), D_MODEL ** -0.5),
        'xattn_w_v': nrm((L, D_MODEL, D_MODEL), D_MODEL ** -0.5),
        'xattn_w_o': nrm((L, D_MODEL, D_MODEL), D_MODEL ** -0.5),
        'norm_moe_g': gain(D_MODEL),
        'moe_w_group': nrm((L, D_MODEL, MOE_GROUPS), D_MODEL ** -0.5),
        'moe_b_group': nrm((L, MOE_GROUPS), 0.01),
        'moe_w_expert': nrm((L, D_MODEL, MOE_GROUPS, MOE_PER_GROUP), D_MODEL ** -0.5),
        'moe_b_expert': nrm((L, MOE_GROUPS, MOE_PER_GROUP), 0.01),
        'moe_w_gate': nrm((L, MOE_EXPERTS, D_MODEL, MOE_FF), D_MODEL ** -0.5),
        'moe_w_up': nrm((L, MOE_EXPERTS, D_MODEL, MOE_FF), D_MODEL ** -0.5),
        'moe_w_down': nrm((L, MOE_EXPERTS, MOE_FF, D_MODEL), MOE_FF ** -0.5),
        'norm_final_g': 1.0 + nrm((D_MODEL,), 0.02),
    }


def reference(x, mem, positions, norm_mix_g, w_in, ssm_lam_re, ssm_lam_im, ssm_log_dt,
              ssm_b_re, ssm_b_im, ssm_c_re, ssm_c_im, ssm_d, ssm_w_glu, ssm_b_glu,
              mla_q_norm_g, mla_w_q_up, mla_kv_norm_g, mla_w_kv_up,
              out_norm_ssm_g, out_norm_mla_g, w_out,
              norm_xattn_g, norm_mem_g, xattn_w_q, xattn_w_k, xattn_w_v, xattn_w_o,
              norm_moe_g, moe_w_group, moe_b_group, moe_w_expert, moe_b_expert,
              moe_w_gate, moe_w_up, moe_w_down, norm_final_g):
    s1 = D_SSM
    s2 = s1 + MLA_Q_RANK
    s3 = s2 + MLA_KV_RANK
    for l in range(DEPTH):
        h = _rms(x, norm_mix_g[l])
        z = h @ w_in[l]
        u_ssm, c_q, c_kv, k_rope = z[..., :s1], z[..., s1:s2], z[..., s2:s3], z[..., s3:]
        y_ssm = _s5_mixer(u_ssm, ssm_lam_re[l], ssm_lam_im[l], ssm_log_dt[l], ssm_b_re[l], ssm_b_im[l],
                          ssm_c_re[l], ssm_c_im[l], ssm_d[l], ssm_w_glu[l], ssm_b_glu[l])
        y_mla = _mla_mixer(c_q, c_kv, k_rope, positions, mla_q_norm_g[l], mla_w_q_up[l],
                           mla_kv_norm_g[l], mla_w_kv_up[l])
        y = jnp.concatenate([_rms(y_ssm, out_norm_ssm_g[l]), _rms(y_mla, out_norm_mla_g[l])], axis=-1)
        x = x + y @ w_out[l]
        h = _rms(x, norm_xattn_g[l])
        x = x + _memory_xattn(h, _rms(mem, norm_mem_g[l]), xattn_w_q[l], xattn_w_k[l],
                              xattn_w_v[l], xattn_w_o[l])
        h = _rms(x, norm_moe_g[l])
        x = x + _hier_moe(h, moe_w_group[l], moe_b_group[l], moe_w_expert[l], moe_b_expert[l],
                          moe_w_gate[l], moe_w_up[l], moe_w_down[l])
    return _rms(x, norm_final_g)
```

```cpp
#define DEBUG_HYBRID 0
#define FASTMASK 0xFFF
#include <hip/hip_runtime.h>
#include <cstdio>
#include <cstdint>

#define LAS __attribute__((address_space(3)))
#define GAS __attribute__((address_space(1)))
typedef unsigned short bf16_t;
typedef short bf16x8 __attribute__((ext_vector_type(8)));
typedef short s16x4 __attribute__((ext_vector_type(4)));
typedef float f32x2 __attribute__((ext_vector_type(2)));
typedef float f32x4 __attribute__((ext_vector_type(4)));
typedef float f32x8 __attribute__((ext_vector_type(8)));
typedef float f32x16 __attribute__((ext_vector_type(16)));
typedef unsigned u32x2 __attribute__((ext_vector_type(2)));
typedef unsigned u32x4 __attribute__((ext_vector_type(4)));

constexpr int T = 16384, DM = 1024, SEQ = 4096, NBATCH = 4, DIN = 1568, ZP = 1792, NMEM = 256;
constexpr int NEXP = 32, LCAP = 16384;
constexpr float EPS = 1e-6f;
constexpr float LOG2E = 1.4426950408889634f;
constexpr float QS = 0.10206207261596577f * LOG2E;
constexpr float XS = 0.0625f * LOG2E;

constexpr size_t MiB = 1u << 20;
constexpr size_t WS_CTL = 0, CTL_ZERO_BYTES = 1 * MiB;
constexpr size_t WS_ROPE = 1 * MiB;
constexpr size_t WS_MEMN = 3 * MiB;
constexpr size_t WS_KX = 5 * MiB;
constexpr size_t WS_VXT = 7 * MiB;
constexpr size_t WS_SC = 9 * MiB;
constexpr size_t WS_TAB = 10 * MiB;
constexpr size_t TAB_ABAR = 0, TAB_A256 = 16384, TAB_BBT = 65536, TAB_CCT = 262144, TAB_WRH = 524288, TAB_WRL = 524288 + 131072;
constexpr size_t WS_LIST = 11 * MiB;
constexpr size_t WS_LISTD = 13 * MiB;
constexpr size_t WS_LISTW = 15 * MiB;
constexpr size_t WS_TOKI = 17 * MiB;
constexpr size_t WS_WT = 18 * MiB;
constexpr size_t WS_A = 82 * MiB;
constexpr size_t WS_Z = 114 * MiB;
constexpr size_t WS_QX = 146 * MiB;
constexpr size_t WS_Q = 170 * MiB;
constexpr size_t WS_PB = 178 * MiB;
constexpr size_t WS_KV = 194 * MiB;
constexpr size_t WS_KPE = 226 * MiB;
constexpr size_t WS_YG = 227 * MiB;
constexpr size_t WS_YMOE = 166 * MiB;
constexpr size_t WS_END = 256 * MiB;
constexpr size_t WT_IN = 0, WT_QUP = WT_IN + (size_t)ZP * 1024, WT_KVUP = WT_QUP + 768 * 768, WT_GLU = WT_KVUP + 1024 * 256, WT_OUT = WT_GLU + 512 * 512,
                 WT_XQ = WT_OUT + 1024 * 1024, WT_XK = WT_XQ + 1024 * 1024, WT_XV = WT_XK + 1024 * 1024, WT_XO = WT_XV + 1024 * 1024,
                 WT_GU = WT_XO + 1024 * 1024, WT_D = WT_GU + (size_t)32 * 512 * 1024, WT_END = WT_D + (size_t)32 * 1024 * 256;
static_assert(WT_END * 2 <= 64 * MiB, "weights fit");
constexpr int CW_TMO = 0, CW_BAR = 4096, CW_CNT = 8192, CW_SSQ = 16384, CW_SSKV = CW_SSQ + 2 * T, CW_SSMLA = CW_SSKV + 2 * T, CW_SSSSM = CW_SSMLA + 2 * T, CW_SSX1 = CW_SSSSM + 2 * T;
static_assert((CW_SSX1 + 2 * T) * 4 <= (int)CTL_ZERO_BYTES, "ctl");
typedef unsigned long long ss_t;

__device__ __forceinline__ unsigned f2bf(float f) { unsigned u = __builtin_bit_cast(unsigned, f); return (u + 0x7fffu + ((u >> 16) & 1u)) >> 16; }
__device__ __forceinline__ float bf2f(unsigned short b) { return __builtin_bit_cast(float, (unsigned)b << 16); }
__device__ __forceinline__ unsigned pk2(float lo, float hi) { return f2bf(lo) | (f2bf(hi) << 16); }
__device__ __forceinline__ float bflo(unsigned w) { return __builtin_bit_cast(float, w << 16); }
__device__ __forceinline__ float bfhi(unsigned w) { return __builtin_bit_cast(float, w & 0xffff0000u); }
__device__ __forceinline__ float wave_sum(float v) {
#pragma unroll
    for (int o = 1; o < 64; o <<= 1) v += __shfl_xor(v, o);
    return v;
}
__device__ __forceinline__ float gelu_tanh(float v) {
    const float z = 0.7978845608028654f * (v + 0.044715f * v * v * v);
    const float e = __expf(2.f * z);
    const float th = 1.f - 2.f / (1.f + e);
    return 0.5f * v * (1.f + th);
}
__device__ __forceinline__ void ss_add(ss_t* p, float s) { atomicAdd(p, (ss_t)(s * 16777216.f)); }
__device__ __forceinline__ float ss_get(const ss_t* p) { return (float)(*p) * (1.f / 16777216.f); }
__device__ __forceinline__ float sigmoidf_(float v) { return 1.f / (1.f + __expf(-v)); }

namespace pg8 {
constexpr int BM = 256, BK = 64, HALF = 128, HTB = HALF * BK * 2, STAGE_BYTES = 8 * HTB, NXCD = 8, WGM = 8;
__host__ __device__ __forceinline__ int lds_byte(int r, int c) { const int st = (r >> 4) * 2 + (c >> 5), rr = r & 15, cc = c & 31, ob = rr * 64 + cc * 2; return st * 1024 + (ob ^ (((ob >> 9) & 1) << 5)); }
__host__ __device__ __forceinline__ void stage_rc(int b, int& R, int& C) { const int st = b / 1024, sb = b % 1024, swz = sb ^ (((sb >> 9) & 1) << 5); R = (st >> 1) * 16 + swz / 64; C = (st & 1) * 32 + (swz % 64) / 2; }
__host__ __device__ __forceinline__ int perm32(int rho) { const int n = rho >> 4, i = rho & 15; return 8 * (i >> 2) + 4 * n + (i & 3); }

struct Unit { int pm, pn, aux; };

struct GridOrder {
    int nM, nN, nwg, G, c;
    __device__ __forceinline__ void init(int nM_, int nN_, int G_, int c_) { nM = nM_; nN = nN_; nwg = nM * nN; G = G_; c = c_; }
    __device__ __forceinline__ bool get(int i, int& pm, int& pn) const {
        if (c < 0 || c >= G) return false;
        const long L = (long)i * G + c; if (L >= nwg) return false;
        int wgid = (int)L; { const int q = nwg / NXCD, r = nwg % NXCD, xcd = wgid % NXCD, off = wgid / NXCD; wgid = (xcd < r ? xcd * (q + 1) : r * (q + 1) + (xcd - r) * q) + off; }
        const int nig = WGM * nN, gid = wgid / nig, fm = gid * WGM, gsz = (nM - fm) < WGM ? (nM - fm) : WGM;
        pm = fm + ((wgid % nig) % gsz); pn = (wgid % nig) / gsz; return true;
    }
};

#define PG8_LAS LAS
template <class Epi, class Prob, bool ALIGN_EPI>
__device__ __forceinline__ void gemm_phase(PG8_LAS unsigned char* lds, const Prob& S, const Epi& E) {
    const int tid = threadIdx.x, wid = __builtin_amdgcn_readfirstlane(tid >> 6), lane = tid & 63, wr = wid >> 2, wc = wid & 3, fr = lane & 15, fq = lane >> 4;
    int R[2], C[2]; unsigned vB[2][2];
#pragma unroll
    for (int i = 0; i < 2; ++i) { stage_rc(tid * 16 + i * 8192, R[i], C[i]); const int Rb = Epi::PERM ? ((R[i] & ~31) + perm32(R[i] & 31)) : R[i];
        vB[0][i] = (unsigned)(Rb * S.ldb + C[i]) * 2u; vB[1][i] = (unsigned)((Rb + HALF) * S.ldb + C[i]) * 2u; }
    const size_t kstep = (size_t)(BK * 2);
    const unsigned ldsw = (unsigned)wid * 1024u;
    const int aoff = lds_byte(wr * 64 + fr, fq * 8), boff = lds_byte(wc * 32 + fr, fq * 8);
#define PG8_SA(b, h) (((b) * 2 + (h)) * HTB)
#define PG8_SB(b, h) ((4 + (b) * 2 + (h)) * HTB)
#define PG8_STAGE(bufoff, gbase, voff) do { _Pragma("unroll") for (int _i = 0; _i < 2; ++_i) \
        __builtin_amdgcn_global_load_lds((const unsigned*)((const char*)(gbase) + (voff)[_i]), (PG8_LAS unsigned*)(lds + (bufoff) + ldsw + _i * 8192), 16, 0, 0); } while (0)
#define PG8_LDA(dst, b, h) do { _Pragma("unroll") for (int m = 0; m < 4; ++m) _Pragma("unroll") for (int k = 0; k < 2; ++k) dst[m][k] = *(const PG8_LAS bf16x8*)(lds + PG8_SA(b, h) + aoff + m * 2048 + k * 1024); } while (0)
#define PG8_LDB(dst, b, h) do { _Pragma("unroll") for (int n = 0; n < 2; ++n) _Pragma("unroll") for (int k = 0; k < 2; ++k) dst[n][k] = *(const PG8_LAS bf16x8*)(lds + PG8_SB(b, h) + boff + n * 2048 + k * 1024); } while (0)
#define PG8_MMA(ai, bj, At, Bt) do { __builtin_amdgcn_s_setprio(1); _Pragma("unroll") for (int m = 0; m < 4; ++m) _Pragma("unroll") for (int n = 0; n < 2; ++n) _Pragma("unroll") for (int k = 0; k < 2; ++k) \
        acc[ai][bj][m][n] = __builtin_amdgcn_mfma_f32_16x16x32_bf16(Bt[n][k], At[m][k], acc[ai][bj][m][n], 0, 0, 0); __builtin_amdgcn_s_setprio(0); } while (0)
#define PG8_WAIT_V(n) asm volatile("s_waitcnt vmcnt(" #n ")" ::: "memory")
#define PG8_WAIT_L(n) asm volatile("s_waitcnt lgkmcnt(" #n ")" ::: "memory")
#define PG8_BAR __builtin_amdgcn_s_barrier()
#define PG8_SCHED __builtin_amdgcn_sched_barrier(0)
    Unit cur, nxt; int ui = 0;
    if (!S.next(0, cur)) return;
    unsigned vA[2][2], vAn[2][2];
    S.a_off(cur, R, C, vA);
    f32x4 acc[2][2][4][2];
#pragma unroll
    for (int a = 0; a < 2; ++a)
#pragma unroll
        for (int b = 0; b < 2; ++b)
#pragma unroll
            for (int m = 0; m < 4; ++m)
#pragma unroll
                for (int n = 0; n < 2; ++n) acc[a][b][m][n] = (f32x4){0.f, 0.f, 0.f, 0.f};
    bf16x8 At[4][2], B0[2][2], B1[2][2];
    const char* cA = S.a_ptr(cur); const char* cB = S.b_ptr(cur);
    int nt = S.nkt(cur);
    PG8_STAGE(PG8_SB(0, 0), cB, vB[0]); PG8_STAGE(PG8_SB(0, 1), cB, vB[1]); PG8_STAGE(PG8_SA(0, 0), cA, vA[0]); PG8_STAGE(PG8_SA(0, 1), cA, vA[1]);
    if (wr == 1) PG8_BAR;
    PG8_WAIT_V(2); PG8_BAR;
    PG8_STAGE(PG8_SB(1, 0), cB + kstep, vB[0]); PG8_STAGE(PG8_SA(1, 0), cA + kstep, vA[0]); PG8_STAGE(PG8_SB(1, 1), cB + kstep, vB[1]);
    PG8_WAIT_V(6); PG8_BAR;
    for (;;) {
        const bool has_next = S.next(ui + 1, nxt);
        const char* nA = has_next ? S.a_ptr(nxt) : cA; const char* nB = has_next ? S.b_ptr(nxt) : cB;
        if constexpr (Prob::GATHER) { if (has_next) S.a_off(nxt, R, C, vAn); else { vAn[0][0] = vA[0][0]; vAn[0][1] = vA[0][1]; vAn[1][0] = vA[1][0]; vAn[1][1] = vA[1][1]; } }
        for (int t = 0; t < nt; t += 2) {
            const bool last = (t == nt - 2);
            const char* a1 = cA + (size_t)(t + 1) * kstep;
            const char* a2 = last ? nA : cA + (size_t)(t + 2) * kstep; const char* b2 = last ? nB : cB + (size_t)(t + 2) * kstep;
            const char* a3 = a2 + kstep; const char* b3 = b2 + kstep;
            unsigned w0[2], w1[2];
            if constexpr (Prob::GATHER) { w0[0] = last ? vAn[0][0] : vA[0][0]; w0[1] = last ? vAn[0][1] : vA[0][1]; w1[0] = last ? vAn[1][0] : vA[1][0]; w1[1] = last ? vAn[1][1] : vA[1][1]; }
            else { w0[0] = vA[0][0]; w0[1] = vA[0][1]; w1[0] = vA[1][0]; w1[1] = vA[1][1]; }
            PG8_LDB(B0, 0, 0); PG8_LDB(B1, 0, 1); PG8_SCHED; PG8_LDA(At, 0, 0); PG8_STAGE(PG8_SA(1, 1), a1, vA[1]);
            PG8_WAIT_V(8); PG8_WAIT_L(0); PG8_BAR; PG8_MMA(0, 0, At, B0); PG8_MMA(0, 1, At, B1); PG8_BAR; PG8_SCHED;
            PG8_LDA(At, 0, 1); PG8_STAGE(PG8_SB(0, 0), b2, vB[0]); PG8_STAGE(PG8_SB(0, 1), b2, vB[1]); PG8_STAGE(PG8_SA(0, 0), a2, w0);
            PG8_WAIT_V(8); PG8_WAIT_L(0); PG8_BAR; PG8_MMA(1, 0, At, B0); PG8_MMA(1, 1, At, B1); PG8_BAR; PG8_SCHED;
            PG8_LDB(B0, 1, 0); PG8_LDB(B1, 1, 1); PG8_SCHED; PG8_LDA(At, 1, 0); PG8_STAGE(PG8_SA(0, 1), a2, w1);
            PG8_WAIT_V(8); PG8_WAIT_L(0); PG8_BAR; PG8_MMA(0, 0, At, B0); PG8_MMA(0, 1, At, B1); PG8_BAR; PG8_SCHED;
            PG8_LDA(At, 1, 1); PG8_STAGE(PG8_SB(1, 0), b3, vB[0]); PG8_STAGE(PG8_SB(1, 1), b3, vB[1]); PG8_STAGE(PG8_SA(1, 0), a3, w0);
            PG8_WAIT_V(8); PG8_WAIT_L(0); PG8_BAR; PG8_MMA(1, 0, At, B0); PG8_MMA(1, 1, At, B1); PG8_BAR; PG8_SCHED;
        }
        if constexpr (ALIGN_EPI) { if (wr == 0) PG8_BAR; }
        if constexpr (!Epi::AFTER_DRAIN) { int fr2 = fr, fq2 = fq; asm volatile("" : "+v"(fr2), "+v"(fq2)); E(acc, cur, wr, wc, fr2, fq2); }
        if (!has_next) break;
#pragma unroll
        for (int a = 0; a < 2; ++a)
#pragma unroll
            for (int b = 0; b < 2; ++b)
#pragma unroll
                for (int m = 0; m < 4; ++m)
#pragma unroll
                    for (int n = 0; n < 2; ++n) acc[a][b][m][n] = (f32x4){0.f, 0.f, 0.f, 0.f};
        cur = nxt; cA = nA; cB = nB; ++ui; nt = S.nkt(cur);
        if constexpr (Prob::GATHER) { vA[0][0] = vAn[0][0]; vA[0][1] = vAn[0][1]; vA[1][0] = vAn[1][0]; vA[1][1] = vAn[1][1]; }
        if constexpr (ALIGN_EPI) { if (wr == 1) PG8_BAR; }
    }
    PG8_WAIT_V(0);
    if constexpr (!ALIGN_EPI) { if (wr == 0) PG8_BAR; }
    PG8_BAR;
    if constexpr (Epi::AFTER_DRAIN) { int fr2 = fr, fq2 = fq; asm volatile("" : "+v"(fr2), "+v"(fq2)); E.fused(acc, cur, wr, wc, fr2, fq2, lds, wid, lane); }
#undef PG8_SA
#undef PG8_SB
#undef PG8_STAGE
#undef PG8_LDA
#undef PG8_LDB
#undef PG8_MMA
#undef PG8_WAIT_V
#undef PG8_WAIT_L
#undef PG8_BAR
#undef PG8_SCHED
}

struct ProbDense {
    static constexpr bool GATHER = false;
    const bf16_t* A; const bf16_t* Bt; int lda, ldb, K; GridOrder O;
    __device__ __forceinline__ bool next(int i, Unit& u) const { u.aux = 0; return O.get(i, u.pm, u.pn); }
    __device__ __forceinline__ int nkt(const Unit&) const { return K / BK; }
    __device__ __forceinline__ const char* a_ptr(const Unit& u) const { return (const char*)(A + (size_t)u.pm * BM * lda); }
    __device__ __forceinline__ const char* b_ptr(const Unit& u) const { return (const char*)(Bt + (size_t)u.pn * BM * ldb); }
    __device__ __forceinline__ void a_off(const Unit&, const int (&R)[2], const int (&C)[2], unsigned (&v)[2][2]) const {
#pragma unroll
        for (int i = 0; i < 2; ++i) { v[0][i] = (unsigned)(R[i] * lda + C[i]) * 2u; v[1][i] = (unsigned)((R[i] + HALF) * lda + C[i]) * 2u; }
    }
};
struct ProbOne {
    static constexpr bool GATHER = false;
    const bf16_t* A; const bf16_t* Bt; int lda, ldb, K, pm, pn;
    __device__ __forceinline__ bool next(int i, Unit& u) const { u.pm = pm; u.pn = pn; u.aux = 0; return i == 0; }
    __device__ __forceinline__ int nkt(const Unit&) const { return K / BK; }
    __device__ __forceinline__ const char* a_ptr(const Unit&) const { return (const char*)A; }
    __device__ __forceinline__ const char* b_ptr(const Unit&) const { return (const char*)Bt; }
    __device__ __forceinline__ void a_off(const Unit&, const int (&R)[2], const int (&C)[2], unsigned (&v)[2][2]) const {
#pragma unroll
        for (int i = 0; i < 2; ++i) { v[0][i] = (unsigned)(R[i] * lda + C[i]) * 2u; v[1][i] = (unsigned)((R[i] + HALF) * lda + C[i]) * 2u; }
    }
};
}

namespace epi {
using pg8::Unit;
typedef f32x4 Acc[2][2][4][2];
__device__ __forceinline__ u32x4 pack8(const f32x4 a, const f32x4 b) { u32x4 w; w.x = pk2(a[0], a[1]); w.y = pk2(a[2], a[3]); w.z = pk2(b[0], b[1]); w.w = pk2(b[2], b[3]); return w; }
__device__ __forceinline__ float sq4(const f32x4 a) { return (a[0] * a[0] + a[1] * a[1]) + (a[2] * a[2] + a[3] * a[3]); }
__device__ __forceinline__ void rope8(f32x4& v0, f32x4& v1, const f32x2* rp  , int fq) {
    float o[8], v[8] = {v0[0], v0[1], v0[2], v0[3], v1[0], v1[1], v1[2], v1[3]};
#pragma unroll
    for (int j = 0; j < 8; ++j) o[j] = __shfl_xor(v[j], 32);
    const int i0 = 8 * (fq & 1);
#pragma unroll
    for (int j = 0; j < 8; ++j) { const f32x2 cs = rp[i0 + j]; v[j] = (fq < 2) ? (v[j] * cs.x - o[j] * cs.y) : (o[j] * cs.y + v[j] * cs.x); }
    v0 = (f32x4){v[0], v[1], v[2], v[3]}; v1 = (f32x4){v[4], v[5], v[6], v[7]};
}

struct EpiZ {
    static constexpr bool PERM = true, AFTER_DRAIN = false;
    bf16_t* z; ss_t* ssq; ss_t* sskv; bf16_t* kpe; const f32x2* rope;
    __device__ __forceinline__ void operator()(const Acc& acc, const Unit& u, int wr, int wc, int fr, int fq) const {
        const int pn = u.pn;
        if (pn < 6) {
#pragma unroll
            for (int ai = 0; ai < 2; ++ai)
#pragma unroll
                for (int m = 0; m < 4; ++m) { const int row = u.pm * 256 + ai * 128 + wr * 64 + m * 16 + fr; float s = 0.f;
#pragma unroll
                    for (int bj = 0; bj < 2; ++bj) { const int col = pn * 256 + bj * 128 + wc * 32 + 8 * fq;
                        *(u32x4*)(z + (size_t)row * ZP + col) = pack8(acc[ai][bj][m][0], acc[ai][bj][m][1]); s += sq4(acc[ai][bj][m][0]) + sq4(acc[ai][bj][m][1]); }
                    if (pn >= 2) { s += __shfl_xor(s, 16); s += __shfl_xor(s, 32); if (fq == 0) ss_add((pn < 5 ? ssq : sskv) + row, s); } }
        } else if (wc == 0) {
#pragma unroll
            for (int ai = 0; ai < 2; ++ai)
#pragma unroll
                for (int m = 0; m < 4; ++m) { const int row = u.pm * 256 + ai * 128 + wr * 64 + m * 16 + fr;
                    f32x4 v0 = acc[ai][0][m][0], v1 = acc[ai][0][m][1]; rope8(v0, v1, rope + (size_t)row * 16, fq);
                    *(u32x4*)(kpe + (size_t)row * 32 + 8 * fq) = pack8(v0, v1); }
        }
    }
};
struct EpiStore {
    static constexpr bool PERM = true, AFTER_DRAIN = false;
    bf16_t* O; int ldc;
    __device__ __forceinline__ void operator()(const Acc& acc, const Unit& u, int wr, int wc, int fr, int fq) const {
#pragma unroll
        for (int ai = 0; ai < 2; ++ai)
#pragma unroll
            for (int m = 0; m < 4; ++m) { const int row = u.pm * 256 + ai * 128 + wr * 64 + m * 16 + fr;
#pragma unroll
                for (int bj = 0; bj < 2; ++bj) { const int col = u.pn * 256 + bj * 128 + wc * 32 + 8 * fq;
                    *(u32x4*)(O + (size_t)row * ldc + col) = pack8(acc[ai][bj][m][0], acc[ai][bj][m][1]); } }
    }
};
struct EpiVXT {
    static constexpr bool PERM = true, AFTER_DRAIN = false;
    bf16_t* O;
    __device__ __forceinline__ void operator()(const Acc& acc, const Unit& u, int wr, int wc, int fr, int fq) const {
#pragma unroll
        for (int ai = 0; ai < 2; ++ai)
#pragma unroll
            for (int m = 0; m < 4; ++m) { const int row = u.pm * 256 + ai * 128 + wr * 64 + m * 16 + fr;
#pragma unroll
                for (int bj = 0; bj < 2; ++bj) { const int key = bj * 128 + wc * 32 + 8 * fq;
                    *(u32x4*)(O + (size_t)u.pn * 262144 + (size_t)row * 256 + key) = pack8(acc[ai][bj][m][0], acc[ai][bj][m][1]); } }
    }
};
struct EpiQ {
    static constexpr bool PERM = true, AFTER_DRAIN = false;
    bf16_t* q; const ss_t* ssq; const f32x2* rope;
    __device__ __forceinline__ void operator()(const Acc& acc, const Unit& u, int wr, int wc, int fr, int fq) const {
#pragma unroll
        for (int ai = 0; ai < 2; ++ai)
#pragma unroll
            for (int m = 0; m < 4; ++m) { const int row = u.pm * 256 + ai * 128 + wr * 64 + m * 16 + fr;
                const float rs = __builtin_amdgcn_rsqf(ss_get(ssq + row) * (1.f / 768.f) + EPS) * QS;
#pragma unroll
                for (int bj = 0; bj < 2; ++bj) { const int g32 = u.pn * 8 + bj * 4 + wc, col = g32 * 32 + 8 * fq;
                    f32x4 v0 = acc[ai][bj][m][0] * rs, v1 = acc[ai][bj][m][1] * rs;
                    if (g32 % 3 == 2) rope8(v0, v1, rope + (size_t)row * 16, fq);
                    *(u32x4*)(q + (size_t)row * 768 + col) = pack8(v0, v1); } }
    }
};
struct EpiKV {
    static constexpr bool PERM = true, AFTER_DRAIN = false;
    bf16_t* kv; const ss_t* sskv;
    __device__ __forceinline__ void operator()(const Acc& acc, const Unit& u, int wr, int wc, int fr, int fq) const {
#pragma unroll
        for (int ai = 0; ai < 2; ++ai)
#pragma unroll
            for (int m = 0; m < 4; ++m) { const int row = u.pm * 256 + ai * 128 + wr * 64 + m * 16 + fr;
                const float rs = __builtin_amdgcn_rsqf(ss_get(sskv + row) * (1.f / 256.f) + EPS);
#pragma unroll
                for (int bj = 0; bj < 2; ++bj) { const int col = u.pn * 256 + bj * 128 + wc * 32 + 8 * fq;
                    *(u32x4*)(kv + (size_t)row * 1024 + col) = pack8(acc[ai][bj][m][0] * rs, acc[ai][bj][m][1] * rs); } }
    }
};
struct EpiGLU {
    static constexpr bool PERM = true, AFTER_DRAIN = false;
    const bf16_t* yg; const float* bias; bf16_t* y; ss_t* ss;
    __device__ __forceinline__ void operator()(const Acc& acc, const Unit& u, int wr, int wc, int fr, int fq) const {
#pragma unroll
        for (int ai = 0; ai < 2; ++ai)
#pragma unroll
            for (int m = 0; m < 4; ++m) { const int row = u.pm * 256 + ai * 128 + wr * 64 + m * 16 + fr; float s = 0.f;
#pragma unroll
                for (int bj = 0; bj < 2; ++bj) { const int col = u.pn * 256 + bj * 128 + wc * 32 + 8 * fq;
                    const u32x4 g = *(const u32x4*)(yg + (size_t)row * 512 + col);
                    const f32x4 b0 = *(const f32x4*)(bias + col), b1 = *(const f32x4*)(bias + col + 4);
                    const f32x4 a0 = acc[ai][bj][m][0] + b0, a1 = acc[ai][bj][m][1] + b1;
                    f32x4 o0, o1;
                    o0[0] = bflo(g.x) * sigmoidf_(a0[0]); o0[1] = bfhi(g.x) * sigmoidf_(a0[1]); o0[2] = bflo(g.y) * sigmoidf_(a0[2]); o0[3] = bfhi(g.y) * sigmoidf_(a0[3]);
                    o1[0] = bflo(g.z) * sigmoidf_(a1[0]); o1[1] = bfhi(g.z) * sigmoidf_(a1[1]); o1[2] = bflo(g.w) * sigmoidf_(a1[2]); o1[3] = bfhi(g.w) * sigmoidf_(a1[3]);
                    s += sq4(o0) + sq4(o1);
                    *(u32x4*)(y + (size_t)row * 1024 + col) = pack8(o0, o1); }
                s += __shfl_xor(s, 16); s += __shfl_xor(s, 32); if (fq == 0) ss_add(ss + row, s); }
    }
};
struct EpiOutA {
    static constexpr bool PERM = false, AFTER_DRAIN = false;
    const float* base; float* out; const ss_t* ss;
    __device__ __forceinline__ void operator()(const Acc& acc, const Unit& u, int wr, int wc, int fr, int fq) const {
#pragma unroll
        for (int ai = 0; ai < 2; ++ai)
#pragma unroll
            for (int m = 0; m < 4; ++m) { const int row = u.pm * 256 + ai * 128 + wr * 64 + m * 16 + fr;
                const float rs = __builtin_amdgcn_rsqf(ss_get(ss + row) * (1.f / 512.f) + EPS);
#pragma unroll
                for (int bj = 0; bj < 2; ++bj)
#pragma unroll
                    for (int n = 0; n < 2; ++n) { const size_t off = (size_t)row * 1024 + u.pn * 256 + bj * 128 + wc * 32 + 16 * n + 4 * fq;
                        *(f32x4*)(out + off) = *(const f32x4*)(base + off) + acc[ai][bj][m][n] * rs; } }
    }
};
struct EpiOutB {
    static constexpr bool PERM = false, AFTER_DRAIN = false;
    float* out; bf16_t* xb; const ss_t* ss; ss_t* ssx;
    __device__ __forceinline__ void operator()(const Acc& acc, const Unit& u, int wr, int wc, int fr, int fq) const {
#pragma unroll
        for (int ai = 0; ai < 2; ++ai)
#pragma unroll
            for (int m = 0; m < 4; ++m) { const int row = u.pm * 256 + ai * 128 + wr * 64 + m * 16 + fr; float s = 0.f;
                const float rs = __builtin_amdgcn_rsqf(ss_get(ss + row) * (1.f / 512.f) + EPS);
#pragma unroll
                for (int bj = 0; bj < 2; ++bj)
#pragma unroll
                    for (int n = 0; n < 2; ++n) { const size_t off = (size_t)row * 1024 + u.pn * 256 + bj * 128 + wc * 32 + 16 * n + 4 * fq;
                        const f32x4 x1 = *(const f32x4*)(out + off) + acc[ai][bj][m][n] * rs; s += sq4(x1);
                        *(f32x4*)(out + off) = x1; u32x2 w; w.x = pk2(x1[0], x1[1]); w.y = pk2(x1[2], x1[3]); *(u32x2*)(xb + off) = w; }
                s += __shfl_xor(s, 16); s += __shfl_xor(s, 32); if (fq == 0) ss_add(ssx + row, s); }
    }
};
struct EpiXQ {
    static constexpr bool PERM = true, AFTER_DRAIN = false;
    bf16_t* O; const ss_t* ss;
    __device__ __forceinline__ void operator()(const Acc& acc, const Unit& u, int wr, int wc, int fr, int fq) const {
#pragma unroll
        for (int ai = 0; ai < 2; ++ai)
#pragma unroll
            for (int m = 0; m < 4; ++m) { const int row = u.pm * 256 + ai * 128 + wr * 64 + m * 16 + fr;
                const float rs = __builtin_amdgcn_rsqf(ss_get(ss + row) * (1.f / 1024.f) + EPS) * XS;
#pragma unroll
                for (int bj = 0; bj < 2; ++bj) { const int col = u.pn * 256 + bj * 128 + wc * 32 + 8 * fq;
                    *(u32x4*)(O + (size_t)row * 1024 + col) = pack8(acc[ai][bj][m][0] * rs, acc[ai][bj][m][1] * rs); } }
    }
};
struct EpiSoft {
    static constexpr bool PERM = true, AFTER_DRAIN = true;
    bf16_t* P; float* lrow;
    __device__ __forceinline__ void fused(Acc& acc, const Unit& u, int wr, int wc, int fr, int fq, LAS unsigned char* lds, int wid, int lane) const {
        LAS float* M1 = (LAS float*)lds;
        LAS float* M2 = (LAS float*)(lds + 4096);
#pragma unroll
        for (int ai = 0; ai < 2; ++ai)
#pragma unroll
            for (int m = 0; m < 4; ++m) { float mx = -3.0e38f;
#pragma unroll
                for (int bj = 0; bj < 2; ++bj)
#pragma unroll
                    for (int n = 0; n < 2; ++n) { const f32x4 x = acc[ai][bj][m][n]; mx = fmaxf(mx, fmaxf(fmaxf(x[0], x[1]), fmaxf(x[2], x[3]))); }
                mx = fmaxf(mx, __shfl_xor(mx, 16)); mx = fmaxf(mx, __shfl_xor(mx, 32));
                if (fq == 0) M1[(ai * 128 + wr * 64 + m * 16 + fr) * 4 + wc] = mx; }
        asm volatile("s_waitcnt lgkmcnt(0)" ::: "memory"); __builtin_amdgcn_s_barrier(); asm volatile("" ::: "memory");
#pragma unroll
        for (int ai = 0; ai < 2; ++ai)
#pragma unroll
            for (int m = 0; m < 4; ++m) { const int r = ai * 128 + wr * 64 + m * 16 + fr; const int row = u.pm * 256 + r;
                const f32x4 mm = *(const LAS f32x4*)(M1 + r * 4); const float mx = fmaxf(fmaxf(mm[0], mm[1]), fmaxf(mm[2], mm[3])); float s = 0.f;
#pragma unroll
                for (int bj = 0; bj < 2; ++bj) { f32x4 p0, p1;
#pragma unroll
                    for (int e = 0; e < 4; ++e) { p0[e] = __builtin_amdgcn_exp2f(acc[ai][bj][m][0][e] - mx); p1[e] = __builtin_amdgcn_exp2f(acc[ai][bj][m][1][e] - mx); }
                    s += (p0[0] + p0[1]) + (p0[2] + p0[3]) + (p1[0] + p1[1]) + (p1[2] + p1[3]);
                    const int col = u.pn * 256 + bj * 128 + wc * 32 + 8 * fq;
                    *(u32x4*)(P + (size_t)row * 1024 + col) = pack8(p0, p1); }
                s += __shfl_xor(s, 16); s += __shfl_xor(s, 32);
                if (fq == 0) M2[r * 4 + wc] = s; }
        asm volatile("s_waitcnt lgkmcnt(0)" ::: "memory"); __builtin_amdgcn_s_barrier(); asm volatile("" ::: "memory");
        if (wid < 4) { const int r = wid * 64 + lane; const f32x4 ss = *(const LAS f32x4*)(M2 + r * 4);
            __hip_atomic_store(lrow + (size_t)(u.pm * 256 + r) * 4 + u.pn, (ss[0] + ss[1]) + (ss[2] + ss[3]), __ATOMIC_RELAXED, __HIP_MEMORY_SCOPE_AGENT); }
    }
};
struct EpiPV {
    static constexpr bool PERM = true, AFTER_DRAIN = false;
    bf16_t* O; const float* lrow;
    __device__ __forceinline__ void operator()(const Acc& acc, const Unit& u, int wr, int wc, int fr, int fq) const {
#pragma unroll
        for (int ai = 0; ai < 2; ++ai)
#pragma unroll
            for (int m = 0; m < 4; ++m) { const int row = u.pm * 256 + ai * 128 + wr * 64 + m * 16 + fr;
                const float rl = 1.f / __hip_atomic_load(lrow + (size_t)row * 4 + u.pn, __ATOMIC_RELAXED, __HIP_MEMORY_SCOPE_AGENT);
#pragma unroll
                for (int bj = 0; bj < 2; ++bj) { const int col = u.pn * 256 + bj * 128 + wc * 32 + 8 * fq;
                    *(u32x4*)(O + (size_t)row * 1024 + col) = pack8(acc[ai][bj][m][0] * rl, acc[ai][bj][m][1] * rl); } }
    }
};
struct EpiAdd {
    static constexpr bool PERM = false, AFTER_DRAIN = false;
    float* out;
    __device__ __forceinline__ void operator()(const Acc& acc, const Unit& u, int wr, int wc, int fr, int fq) const {
#pragma unroll
        for (int ai = 0; ai < 2; ++ai)
#pragma unroll
            for (int m = 0; m < 4; ++m) { const int row = u.pm * 256 + ai * 128 + wr * 64 + m * 16 + fr;
#pragma unroll
                for (int bj = 0; bj < 2; ++bj)
#pragma unroll
                    for (int n = 0; n < 2; ++n) { const size_t off = (size_t)row * 1024 + u.pn * 256 + bj * 128 + wc * 32 + 16 * n + 4 * fq;
                        *(f32x4*)(out + off) = *(const f32x4*)(out + off) + acc[ai][bj][m][n]; } }
    }
};
}

namespace mla {
constexpr int NW = 8, QBLK = 32, KVBLK = 64;
constexpr int SHM_V = KVBLK * 64 * 2, SHM_K = KVBLK * 256;
constexpr int LDS_V = 0, LDS_K = 2 * SHM_V, LDS_WS = LDS_K + 2 * SHM_K, LDS_BYTES = LDS_WS + NW * 64 * 4;
constexpr float THR = 8.f;
#define KSWZ(row, colB) ((row) * 256 + ((colB) ^ (((row) & 7) << 4)))
#define SBAR() __builtin_amdgcn_sched_barrier(0)
__device__ __forceinline__ int crow(int r, int hi) { return (r & 3) + 8 * (r >> 2) + 4 * hi; }
__device__ __forceinline__ unsigned cvtpk(float lo, float hi) { unsigned r; asm volatile("v_cvt_pk_bf16_f32 %0, %1, %2" : "=v"(r) : "v"(lo), "v"(hi)); return r; }
__device__ __forceinline__ void partialSM(f32x16& p0, f32x16& p1, float& m_reg, float& mn, float& alpha) {
    float pmax = p0[0];
#pragma unroll
    for (int r = 1; r < 16; ++r) pmax = fmaxf(pmax, p0[r]);
#pragma unroll
    for (int r = 0; r < 16; ++r) pmax = fmaxf(pmax, p1[r]);
    { auto rr = __builtin_amdgcn_permlane32_swap(__float_as_uint(pmax), __float_as_uint(pmax), false, false); pmax = fmaxf(__uint_as_float(rr[0]), __uint_as_float(rr[1])); }
    if (__builtin_expect(__all(pmax - m_reg <= THR), 1)) { mn = m_reg; alpha = 1.f; }
    else { mn = fmaxf(m_reg, pmax); alpha = __builtin_amdgcn_exp2f(m_reg - mn); m_reg = mn; }
#pragma unroll
    for (int r = 0; r < 16; ++r) p0[r] = p0[r] - mn;
#pragma unroll
    for (int r = 0; r < 16; ++r) p1[r] = p1[r] - mn;
#pragma unroll
    for (int r = 0; r < 16; ++r) p0[r] = __builtin_amdgcn_exp2f(p0[r]);
}
__device__ __forceinline__ void finishSM(f32x16& p0, f32x16& p1, float alpha, float& l_reg, bf16x8& pa0, bf16x8& pa1, bf16x8& pa2, bf16x8& pa3) {
#pragma unroll
    for (int r = 0; r < 16; ++r) p1[r] = __builtin_amdgcn_exp2f(p1[r]);
    float ps = 0;
#pragma unroll
    for (int r = 0; r < 16; ++r) ps += p0[r];
#pragma unroll
    for (int r = 0; r < 16; ++r) ps += p1[r];
    { auto rr = __builtin_amdgcn_permlane32_swap(__float_as_uint(ps), __float_as_uint(ps), false, false); ps = __uint_as_float(rr[0]) + __uint_as_float(rr[1]); }
    l_reg = l_reg * alpha + ps;
#define PK4(P, BASE, OUT) do { unsigned a0 = cvtpk(P[BASE + 0], P[BASE + 1]), a1 = cvtpk(P[BASE + 2], P[BASE + 3]);   \
    unsigned b0 = cvtpk(P[BASE + 4], P[BASE + 5]), b1 = cvtpk(P[BASE + 6], P[BASE + 7]);                              \
    auto r0 = __builtin_amdgcn_permlane32_swap(a0, b0, false, false); auto r1 = __builtin_amdgcn_permlane32_swap(a1, b1, false, false); \
    u32x4 w = {r0[0], r1[0], r0[1], r1[1]}; OUT = *reinterpret_cast<bf16x8*>(&w); } while (0)
    PK4(p0, 0, pa0); PK4(p0, 8, pa1); PK4(p1, 0, pa2); PK4(p1, 8, pa3);
#undef PK4
}
__device__ __forceinline__ void qkt(f32x16& p0, f32x16& p1, const char* Ks, const bf16x8* qr, int r32, int hi, bool masked) {
    p0 = f32x16{}; p1 = f32x16{};
#pragma unroll
    for (int d0 = 0; d0 < 6; ++d0) { const int cb = (d0 * 16 + hi * 8) * 2;
        const bf16x8 b0 = *reinterpret_cast<const bf16x8*>(Ks + KSWZ(r32, cb));
        const bf16x8 b1 = *reinterpret_cast<const bf16x8*>(Ks + KSWZ(32 + r32, cb));
        p0 = __builtin_amdgcn_mfma_f32_32x32x16_bf16(b0, qr[d0], p0, 0, 0, 0);
        p1 = __builtin_amdgcn_mfma_f32_32x32x16_bf16(b1, qr[d0], p1, 0, 0, 0); }
    if (masked) {
#pragma unroll
        for (int r = 0; r < 16; ++r) { p0[r] = -INFINITY; p1[r] = -INFINITY; } }
}
__device__ __forceinline__ int v_st(int k, int c) { const int kk = (k & ~0xC) | ((k & 4) << 1) | ((k & 8) >> 1); return ((kk >> 3) * 2 + (c >> 5)) * 512 + ((kk & 7) * 32 + (c & 31)) * 2; }
__device__ __forceinline__ int v_rd_base(int lane) { return ((lane & 3) << 3) | (((lane >> 2) & 3) << 6) | (((lane >> 4) & 1) << 5) | (((lane >> 5) & 1) << 8); }
constexpr int v_rd_off(int d0, int ks, int half) { return d0 * 512 + ks * 2048 + half * 1024; }
template <int OFF> __device__ __forceinline__ s16x4 tr_read(int vb) { s16x4 r; asm volatile("ds_read_b64_tr_b16 %0, %1 offset:%2" : "=&v"(r) : "v"(vb), "i"(OFF) : "memory"); return r; }
template <int D0> __device__ __forceinline__ void pv_one(f32x16& od, int vb, bf16x8 pa0, bf16x8 pa1, bf16x8 pa2, bf16x8 pa3) {
    const s16x4 l0 = tr_read<v_rd_off(D0, 0, 0)>(vb), h0 = tr_read<v_rd_off(D0, 0, 1)>(vb), l1 = tr_read<v_rd_off(D0, 1, 0)>(vb), h1 = tr_read<v_rd_off(D0, 1, 1)>(vb);
    const s16x4 l2 = tr_read<v_rd_off(D0, 2, 0)>(vb), h2 = tr_read<v_rd_off(D0, 2, 1)>(vb), l3 = tr_read<v_rd_off(D0, 3, 0)>(vb), h3 = tr_read<v_rd_off(D0, 3, 1)>(vb);
    asm volatile("s_waitcnt lgkmcnt(0)" ::: "memory"); SBAR();
#define PK(L, H) (bf16x8){L[0], L[1], L[2], L[3], H[0], H[1], H[2], H[3]}
    od = __builtin_amdgcn_mfma_f32_32x32x16_bf16(pa0, PK(l0, h0), od, 0, 0, 0);
    od = __builtin_amdgcn_mfma_f32_32x32x16_bf16(pa1, PK(l1, h1), od, 0, 0, 0);
    od = __builtin_amdgcn_mfma_f32_32x32x16_bf16(pa2, PK(l2, h2), od, 0, 0, 0);
    od = __builtin_amdgcn_mfma_f32_32x32x16_bf16(pa3, PK(l3, h3), od, 0, 0, 0);
#undef PK
}
__device__ __forceinline__ void pv_d0(f32x16* o, int vb, bf16x8 pa0, bf16x8 pa1, bf16x8 pa2, bf16x8 pa3) { pv_one<0>(o[0], vb, pa0, pa1, pa2, pa3); pv_one<1>(o[1], vb, pa0, pa1, pa2, pa3); }

__device__ __forceinline__ void unit(int b, int h, int qb, const bf16_t* __restrict__ q, const bf16_t* __restrict__ kv, const bf16_t* __restrict__ kpe, bf16_t* y, ss_t* ssm, char* lds) {
    const int tid = threadIdx.x, wid = tid >> 6, lane = tid & 63, r32 = lane & 31, hi = lane >> 5;
    char* V_lds = lds + LDS_V; char* K_lds = lds + LDS_K;
    float* ws = (float*)(lds + LDS_WS) + wid * 64; float* li_l = ws; float* al_l = ws + 32;
    float m_reg = -1e30f, l_reg = 0; f32x16 o[2] = {}; bf16x8 qr[6];
    const size_t row0 = (size_t)b * SEQ + (size_t)qb * 256, krow0 = (size_t)b * SEQ;
    const bf16_t* Qw = q + (row0 + wid * QBLK + r32) * 768 + h * 96 + hi * 8;
#pragma unroll
    for (int d0 = 0; d0 < 6; ++d0) qr[d0] = *reinterpret_cast<const bf16x8*>(Qw + d0 * 16);
    const int skey = tid >> 3, sc = (tid & 7) * 8, pkey = (tid & 255) >> 2, pc = (tid & 3) * 8;
    const int vst = v_st(skey, sc), kst = KSWZ(skey, sc * 2), pst = KSWZ(pkey, (64 + pc) * 2);
    const int vb0 = (int)(uintptr_t)V_lds + v_rd_base(lane);
    const char* kvb = (const char*)(kv + krow0 * 1024 + h * 128);
    const char* kpb = (const char*)(kpe + krow0 * 32);
    const unsigned koff = (unsigned)(skey * 1024 + sc) * 2u, poff = (unsigned)(pkey * 32 + pc) * 2u;
    struct { bf16x8 v, k, p; } sr_[2];
#define SLOAD(i, k0) do { const char* kb_ = kvb + (size_t)(k0) * 2048; sr_[i].v = *reinterpret_cast<const bf16x8*>(kb_ + 128 + koff); sr_[i].k = *reinterpret_cast<const bf16x8*>(kb_ + koff); \
    sr_[i].p = *reinterpret_cast<const bf16x8*>(kpb + (size_t)(k0) * 64 + poff); } while (0)
#define SWRITE(bb, i) do { *(bf16x8*)(V_lds + (bb) * SHM_V + vst) = sr_[i].v; *(bf16x8*)(K_lds + (bb) * SHM_K + kst) = sr_[i].k; \
    if (tid < 256) *(bf16x8*)(K_lds + (bb) * SHM_K + pst) = sr_[i].p; } while (0)
#define SWAIT() asm volatile("s_waitcnt vmcnt(3)" ::: "memory")
#define RESC(a) do { if (__any((a) < 1.f)) { if (hi == 0) al_l[r32] = (a); asm volatile("s_waitcnt lgkmcnt(0)" ::: "memory"); \
    _Pragma("unroll") for (int d = 0; d < 2; ++d) _Pragma("unroll") for (int r = 0; r < 16; ++r) o[d][r] *= al_l[crow(r, hi)]; } } while (0)
    f32x16 pA0, pA1, pB0, pB1; float mnA, mnB, alA, alB; bf16x8 pa0, pa1, pa2, pa3;
    const int NT = 4 * qb + 4, tmax = 4 * qb + (wid >> 1);
    constexpr int SE = 0, SO = 1;
    SLOAD(SE, 0); asm volatile("s_waitcnt vmcnt(0)" ::: "memory"); SWRITE(0, SE); __syncthreads();
    qkt(pA0, pA1, K_lds, qr, r32, hi, false); partialSM(pA0, pA1, m_reg, mnA, alA);
    SLOAD(SO, KVBLK); if (2 < NT) SLOAD(SE, 2 * KVBLK);
    SWAIT(); SWRITE(1, SO); __syncthreads();
    for (int j = 1; j + 1 < NT; j += 2) {
        SBAR(); qkt(pB0, pB1, K_lds + SHM_K, qr, r32, hi, j > tmax);
        finishSM(pA0, pA1, alA, l_reg, pa0, pa1, pa2, pa3); SBAR();
        SLOAD(SO, (j + 2) * KVBLK); SBAR();
        pv_d0(o, vb0, pa0, pa1, pa2, pa3); partialSM(pB0, pB1, m_reg, mnB, alB);
        __syncthreads(); SWAIT(); SWRITE(0, SE);
        RESC(alB); __syncthreads();
        SBAR(); qkt(pA0, pA1, K_lds, qr, r32, hi, (j + 1) > tmax);
        finishSM(pB0, pB1, alB, l_reg, pa0, pa1, pa2, pa3); SBAR();
        if (j + 3 < NT) SLOAD(SE, (j + 3) * KVBLK); SBAR();
        pv_d0(o, vb0 + SHM_V, pa0, pa1, pa2, pa3); partialSM(pA0, pA1, m_reg, mnA, alA);
        __syncthreads(); SWAIT(); SWRITE(1, SO);
        RESC(alA); __syncthreads();
    }
    SBAR(); qkt(pB0, pB1, K_lds + SHM_K, qr, r32, hi, (NT - 1) > tmax);
    finishSM(pA0, pA1, alA, l_reg, pa0, pa1, pa2, pa3); SBAR();
    pv_d0(o, vb0, pa0, pa1, pa2, pa3); partialSM(pB0, pB1, m_reg, mnB, alB);
    __syncthreads(); RESC(alB);
    finishSM(pB0, pB1, alB, l_reg, pa0, pa1, pa2, pa3); SBAR();
    pv_d0(o, vb0 + SHM_V, pa0, pa1, pa2, pa3);
    if (hi == 0) li_l[r32] = l_reg; asm volatile("s_waitcnt lgkmcnt(0)" ::: "memory");
    float rli[16];
#pragma unroll
    for (int r = 0; r < 16; ++r) rli[r] = __builtin_amdgcn_rcpf(li_l[crow(r, hi)]);
    bf16_t* Ow = y + (row0 + wid * QBLK) * 1024 + 512 + h * 64;
#pragma unroll
    for (int r = 0; r < 16; ++r) { const int orow = crow(r, hi); const float a = o[0][r] * rli[r], c = o[1][r] * rli[r];
        Ow[(size_t)orow * 1024 + r32] = (bf16_t)f2bf(a); Ow[(size_t)orow * 1024 + 32 + r32] = (bf16_t)f2bf(c);
        float s = a * a + c * c;
        s += __shfl_xor(s, 1); s += __shfl_xor(s, 2); s += __shfl_xor(s, 4); s += __shfl_xor(s, 8); s += __shfl_xor(s, 16);
        if (r32 == 0) ss_add(ssm + row0 + wid * QBLK + orow, s); }
    __syncthreads();
#undef SLOAD
#undef SWRITE
#undef SWAIT
#undef RESC
}
#undef KSWZ
#undef SBAR
}

namespace ssm {
__device__ __forceinline__ int crow(int r, int hi) { return (r & 3) + 8 * (r >> 2) + 4 * hi; }
template <bool FINAL>
__device__ __forceinline__ void item(int it, const bf16_t* z, const f32x2* abar, const f32x2* a256, const bf16_t* BBT, const bf16_t* CCT, const float* dskip,
                                     float* Sc, bf16_t* yg, LAS bf16_t* xl, int lane) {
    const int c = it & 15, g = (it >> 4) & 31, b = it >> 9, r32 = lane & 31, hi = lane >> 5;
    const size_t t0 = (size_t)b * SEQ + (size_t)c * 256;
    bf16x8 bb[4];
#pragma unroll
    for (int nb = 0; nb < 4; ++nb) bb[nb] = *(const bf16x8*)(BBT + ((size_t)(g * 128 + nb * 32 + r32) * 16 + hi * 8));
    const f32x2 a0 = abar[g * 64 + r32], a1 = abar[g * 64 + 32 + r32];
    float xr0 = 0.f, xi0 = 0.f, xr1 = 0.f, xi1 = 0.f;
    bf16x8 cc[8]; float dsk[16];
    if constexpr (FINAL) {
        const f32x2 A0 = a256[g * 64 + r32], A1 = a256[g * 64 + 32 + r32];
        for (int k = 0; k < c; ++k) { const float* S = Sc + (size_t)((b * 32 + g) * 16 + k) * 128;
            const float s0r = S[r32], s0i = S[32 + r32], s1r = S[64 + r32], s1i = S[96 + r32];
            const float n0r = A0.x * xr0 - A0.y * xi0 + s0r, n0i = A0.x * xi0 + A0.y * xr0 + s0i, n1r = A1.x * xr1 - A1.y * xi1 + s1r, n1i = A1.x * xi1 + A1.y * xr1 + s1i;
            xr0 = n0r; xi0 = n0i; xr1 = n1r; xi1 = n1i; }
#pragma unroll
        for (int s = 0; s < 8; ++s) cc[s] = *(const bf16x8*)(CCT + ((size_t)(g * 32 + r32) * 128 + s * 16 + hi * 8));
#pragma unroll
        for (int j = 0; j < 16; ++j) dsk[j] = dskip[g * 16 + j];
    }
#pragma unroll 1
    for (int blk = 0; blk < 8; ++blk) {
        const bf16x8 u8 = *(const bf16x8*)(z + (t0 + blk * 32 + r32) * ZP + g * 16 + hi * 8);
        f32x16 X[4];
#pragma unroll
        for (int nb = 0; nb < 4; ++nb) X[nb] = __builtin_amdgcn_mfma_f32_32x32x16_bf16(u8, bb[nb], f32x16{}, 0, 0, 0);
#pragma unroll
        for (int grp = 0; grp < 8; ++grp) { const int owner = grp & 1, rb = 4 * (grp >> 1);
            if (hi == owner) {
#pragma unroll
                for (int i = 0; i < 4; ++i) { const int r = rb + i;
                    const float n0r = a0.x * xr0 - a0.y * xi0 + X[0][r], n0i = a0.x * xi0 + a0.y * xr0 + X[1][r];
                    const float n1r = a1.x * xr1 - a1.y * xi1 + X[2][r], n1i = a1.x * xi1 + a1.y * xr1 + X[3][r];
                    xr0 = n0r; xi0 = n0i; xr1 = n1r; xi1 = n1i; X[0][r] = n0r; X[1][r] = n0i; X[2][r] = n1r; X[3][r] = n1i; } }
            const float t0r = __shfl_xor(xr0, 32), t0i = __shfl_xor(xi0, 32), t1r = __shfl_xor(xr1, 32), t1i = __shfl_xor(xi1, 32);
            if (hi != owner) { xr0 = t0r; xi0 = t0i; xr1 = t1r; xi1 = t1i; } }
        if constexpr (FINAL) {
#pragma unroll
            for (int nb = 0; nb < 4; ++nb)
#pragma unroll
                for (int r = 0; r < 16; ++r) xl[crow(r, hi) * 136 + nb * 32 + r32] = (bf16_t)f2bf(X[nb][r]);
            asm volatile("s_waitcnt lgkmcnt(0)" ::: "memory");
            f32x16 yv = f32x16{};
#pragma unroll
            for (int s = 0; s < 8; ++s) { const bf16x8 xa = *(const LAS bf16x8*)(xl + r32 * 136 + s * 16 + hi * 8); yv = __builtin_amdgcn_mfma_f32_32x32x16_bf16(xa, cc[s], yv, 0, 0, 0); }
            asm volatile("s_waitcnt lgkmcnt(0)" ::: "memory");
            LAS float* yl = (LAS float*)(xl + 32 * 136);
            if (r32 < 16) {
#pragma unroll
                for (int r = 0; r < 16; ++r) yl[crow(r, hi) * 17 + r32] = yv[r]; }
            asm volatile("s_waitcnt lgkmcnt(0)" ::: "memory");
            { const int tl = lane >> 1, hh = lane & 1; const size_t tok = t0 + blk * 32 + tl;
              const u32x4 uw = *(const u32x4*)(z + tok * ZP + g * 16 + hh * 8);
              const float uu[8] = {bflo(uw.x), bfhi(uw.x), bflo(uw.y), bfhi(uw.y), bflo(uw.z), bfhi(uw.z), bflo(uw.w), bfhi(uw.w)};
              float ov[8];
#pragma unroll
              for (int j = 0; j < 8; ++j) ov[j] = gelu_tanh(yl[tl * 17 + hh * 8 + j] + dsk[hh * 8 + j] * uu[j]);
              u32x4 ow; ow.x = pk2(ov[0], ov[1]); ow.y = pk2(ov[2], ov[3]); ow.z = pk2(ov[4], ov[5]); ow.w = pk2(ov[6], ov[7]);
              *(u32x4*)(yg + tok * 512 + g * 16 + hh * 8) = ow; }
            asm volatile("s_waitcnt lgkmcnt(0)" ::: "memory");
        }
    }
    if constexpr (!FINAL) { if (hi == 0) { float* S = Sc + (size_t)it * 128; S[r32] = xr0; S[32 + r32] = xi0; S[64 + r32] = xr1; S[96 + r32] = xi1; } }
}
}

namespace moe {
using pg8::Unit;
struct Ctx { const LAS int* tmap; int ntile; const unsigned* cnt; const int* list; const int* listd; const float* listw; const float* rstd3; };
struct ProbGU {
    static constexpr bool GATHER = true;
    const bf16_t* A; const bf16_t* Bt; int ldb; Ctx X; int G, c;
    __device__ __forceinline__ bool next(int i, Unit& u) const { const int L = i * G + c; if (L >= X.ntile * 2) return false; u.pm = L >> 1; u.pn = L & 1; u.aux = X.tmap[u.pm]; return true; }
    __device__ __forceinline__ int nkt(const Unit&) const { return 16; }
    __device__ __forceinline__ const char* a_ptr(const Unit&) const { return (const char*)A; }
    __device__ __forceinline__ const char* b_ptr(const Unit& u) const { return (const char*)(Bt + ((size_t)(u.aux & 255) * 512 + u.pn * 256) * 1024); }
    __device__ __forceinline__ void a_off(const Unit& u, const int (&R)[2], const int (&C)[2], unsigned (&v)[2][2]) const {
        const int e = u.aux & 255, rt = u.aux >> 8; const int n = (int)X.cnt[e];
#pragma unroll
        for (int h = 0; h < 2; ++h)
#pragma unroll
            for (int i = 0; i < 2; ++i) { const int pos = rt * 256 + h * 128 + R[i]; const int tok = pos < n ? X.list[e * LCAP + pos] : 0; v[h][i] = (unsigned)(tok * 1024 + C[i]) * 2u; }
    }
};
struct EpiGU {
    static constexpr bool PERM = true, AFTER_DRAIN = false;
    bf16_t* h1; Ctx X;
    __device__ __forceinline__ void operator()(const epi::Acc& acc, const Unit& u, int wr, int wc, int fr, int fq) const {
        const int e = u.aux & 255, rt = u.aux >> 8; const int n = (int)X.cnt[e];
#pragma unroll
        for (int ai = 0; ai < 2; ++ai)
#pragma unroll
            for (int m = 0; m < 4; ++m) { const int r = ai * 128 + wr * 64 + m * 16 + fr, pos = rt * 256 + r; const size_t srow = (size_t)u.pm * 256 + r;
                const int tok = pos < n ? X.list[e * LCAP + pos] : 0; const float rs = X.rstd3[tok];
                f32x4 o0, o1;
#pragma unroll
                for (int k = 0; k < 4; ++k) { const float g0 = acc[ai][0][m][0][k] * rs, u0 = acc[ai][1][m][0][k] * rs, g1 = acc[ai][0][m][1][k] * rs, u1 = acc[ai][1][m][1][k] * rs;
                    o0[k] = g0 * sigmoidf_(g0) * u0; o1[k] = g1 * sigmoidf_(g1) * u1; }
                *(u32x4*)(h1 + srow * 256 + u.pn * 128 + wc * 32 + 8 * fq) = epi::pack8(o0, o1); asm volatile("" ::: "memory"); }
    }
};
struct ProbD {
    static constexpr bool GATHER = false;
    const bf16_t* A; const bf16_t* Bt; int ldb; Ctx X; int G, c, nk;
    __device__ __forceinline__ bool next(int i, Unit& u) const { const int L = i * G + c; if (L >= X.ntile * 4) return false; u.pm = L >> 2; u.pn = L & 3; u.aux = X.tmap[u.pm]; return true; }
    __device__ __forceinline__ int nkt(const Unit&) const { return nk; }
    __device__ __forceinline__ const char* a_ptr(const Unit& u) const { return (const char*)(A + (size_t)u.pm * 256 * 256); }
    __device__ __forceinline__ const char* b_ptr(const Unit& u) const { return (const char*)(Bt + ((size_t)(u.aux & 255) * 1024 + u.pn * 256) * 256); }
    __device__ __forceinline__ void a_off(const Unit&, const int (&R)[2], const int (&C)[2], unsigned (&v)[2][2]) const {
#pragma unroll
        for (int i = 0; i < 2; ++i) { v[0][i] = (unsigned)(R[i] * 256 + C[i]) * 2u; v[1][i] = (unsigned)((R[i] + 128) * 256 + C[i]) * 2u; }
    }
};
struct EpiD {
    static constexpr bool PERM = true, AFTER_DRAIN = false;
    bf16_t* ymoe; Ctx X;
    __device__ __forceinline__ void operator()(const epi::Acc& acc, const Unit& u, int wr, int wc, int fr, int fq) const {
        const int e = u.aux & 255, rt = u.aux >> 8; const int n = (int)X.cnt[e];
#pragma unroll
        for (int ai = 0; ai < 2; ++ai)
#pragma unroll
            for (int m = 0; m < 4; ++m) { const int r = ai * 128 + wr * 64 + m * 16 + fr, pos = rt * 256 + r;
                const bool ok = pos < n; const int li = ok ? e * LCAP + pos : 0; const int dst = ok ? X.listd[li] : 2 * T; const float w = ok ? X.listw[li] : 0.f;
#pragma unroll
                for (int bj = 0; bj < 2; ++bj) { const int col = u.pn * 256 + bj * 128 + wc * 32 + 8 * fq;
                    *(u32x4*)(ymoe + (size_t)dst * 1024 + col) = epi::pack8(acc[ai][bj][m][0] * w, acc[ai][bj][m][1] * w); }
                asm volatile("" ::: "memory"); }
    }
};
}

typedef GAS unsigned gu32;
#define RLX_AGENT __ATOMIC_RELAXED, __HIP_MEMORY_SCOPE_AGENT
#define XB_TMO      128
#define XB_XCNT(j)  (256  + 64 * (j))
#define XB_XSUB(j)  (1280 + 64 * (j))
#define XB_XGEN(j)  (2304 + 64 * (j))
#define XB_TOP      3328
#define XB_TOPGEN   3392
#define XCD_BAR_WORDS 3456
#define XB_SPIN_CAP (1u << 18)
__device__ __forceinline__ unsigned xb_ld(unsigned* p)              { return __hip_atomic_load(p, __ATOMIC_RELAXED, __HIP_MEMORY_SCOPE_AGENT); }
__device__ __forceinline__ unsigned xb_add(unsigned* p, unsigned v) { return __hip_atomic_fetch_add(p, v, __ATOMIC_RELAXED, __HIP_MEMORY_SCOPE_AGENT); }
__device__ __forceinline__ unsigned xb_xcc_id() { return (unsigned)__builtin_amdgcn_s_getreg((3 << 11) | 20) & 0xFu; }
#define XB_SPIN(cond, bar) do { unsigned _sp = 0; while (cond) { __builtin_amdgcn_s_sleep(1); \
    if ((++_sp & 255u) == 0u) { if (xb_ld(&(bar)[XB_TMO])) break; if (_sp > XB_SPIN_CAP) { atomicAdd(&(bar)[XB_TMO], 1u); break; } } } } while (0)
struct XcdBarrier { unsigned* bar; unsigned x; volatile LAS unsigned* st; };
__device__ __forceinline__ XcdBarrier xcd_barrier_post(unsigned* bar, volatile LAS unsigned* st) {
    XcdBarrier b; b.bar = bar; b.x = xb_xcc_id(); b.st = st;
    if (threadIdx.x == 0) (void)xb_add(&bar[XB_XCNT(b.x)], 1u);
    return b;
}
__device__ __forceinline__ void xcd_barrier_complete(unsigned* bar, unsigned x, unsigned& nloc, unsigned& nx) {
    const unsigned G = gridDim.x * gridDim.y * gridDim.z;
    unsigned sum, cnt, mine, sp = 0u;
    for (;;) {
        sum = 0u; cnt = 0u; mine = 0u;
#pragma unroll
        for (unsigned j = 0; j < 16; ++j) { const unsigned c = xb_ld(&bar[XB_XCNT(j)]); sum += c; cnt += (c > 0u) ? 1u : 0u; mine = (j == x) ? c : mine; }
        if (sum == G) break;
        __builtin_amdgcn_s_sleep(1);
        if ((++sp & 255u) == 0u) { if (xb_ld(&bar[XB_TMO])) break; if (sp > XB_SPIN_CAP) { atomicAdd(&bar[XB_TMO], 1u); break; } }
    }
    nloc = mine > 0u ? mine : 1u; nx = cnt > 0u ? cnt : 1u;
}
__device__ __forceinline__ void xcd_barrier(const XcdBarrier& b) {
    asm volatile("s_waitcnt vmcnt(0)" ::: "memory");
    __syncthreads();
    if (threadIdx.x == 0) {
        unsigned* bar = b.bar;
        __builtin_amdgcn_s_waitcnt(0);
        unsigned nloc = b.st[0], nx = b.st[1];
        if (nloc == 0u) { xcd_barrier_complete(bar, b.x, nloc, nx); b.st[0] = nloc; b.st[1] = nx; }
        const unsigned old = xb_add(&bar[XB_XSUB(b.x)], 1u);
        const unsigned gen = old / nloc;
        if (old + 1u == (gen + 1u) * nloc) {
            __builtin_amdgcn_fence(__ATOMIC_RELEASE, "agent");
            asm volatile("s_waitcnt vmcnt(0)" ::: "memory");
            const unsigned og = xb_add(&bar[XB_TOP], 1u);
            const unsigned tg = og / nx;
            if (og + 1u == (tg + 1u) * nx) xb_add(&bar[XB_TOPGEN], 1u);
            else XB_SPIN(xb_ld(&bar[XB_TOPGEN]) == tg, bar);
            __builtin_amdgcn_fence(__ATOMIC_ACQUIRE, "agent");
            xb_add(&bar[XB_XGEN(b.x)], 1u);
            asm volatile("s_waitcnt vmcnt(0)" ::: "memory");
        } else {
            XB_SPIN(xb_ld(&bar[XB_XGEN(b.x)]) == gen, bar);
            __builtin_amdgcn_fence(__ATOMIC_ACQUIRE, "agent");
            asm volatile("s_waitcnt vmcnt(0)" ::: "memory");
        }
    }
    __syncthreads();
}
__device__ __forceinline__ void cu_sync_global() {
    asm volatile("s_waitcnt vmcnt(0)" ::: "memory");
    __syncthreads();
    if (threadIdx.x == 0) { __builtin_amdgcn_fence(__ATOMIC_ACQUIRE, "agent"); asm volatile("s_waitcnt vmcnt(0)" ::: "memory"); }
    __syncthreads();
}

constexpr int NWAVES = 8;
constexpr int RING_BYTES = 131072, LDSCTL_OFF = RING_BYTES, MISC_OFF = LDSCTL_OFF + 320, TMAP_OFF = LDSCTL_OFF + 1024, LDS_BYTES = 147456;
struct Args { const void* in[37]; float* out; unsigned char* ws; int ph_lo, ph_hi; };
enum { I_X = 0, I_MEM, I_POS, I_GMIX, I_WIN, I_LRE, I_LIM, I_LDT, I_BRE, I_BIM, I_CRE, I_CIM, I_SD, I_WGLU, I_BGLU, I_GQ, I_WQUP, I_GKV, I_WKVUP, I_GSSM, I_GMLA, I_WOUT,
       I_GX, I_GMEM, I_XWQ, I_XWK, I_XWV, I_XWO, I_GMOE, I_WGRP, I_BGRP, I_WEXP, I_BEXP, I_WGATE, I_WUP, I_WDOWN, I_GFIN };

struct Frame {
    LAS unsigned char* lds; unsigned char* ws; float* out; const void* const* in;
    int tid, lane, wave, vcu, G;
    __device__ __forceinline__ const float* f(int i) const { return (const float*)in[i]; }
    __device__ __forceinline__ bf16_t* wt(size_t off) const { return (bf16_t*)(ws + WS_WT) + off; }
    __device__ __forceinline__ ss_t* ctlf(int w) const { return (ss_t*)((unsigned*)(ws + WS_CTL) + w); }
};

__device__ __forceinline__ void tr_item(const float* W, int N, bf16_t* WT, int ldk, int k0, int n0, int drow0, const float* g0, const float* g1, LAS float* scr, int lane) {
#pragma unroll 8
    for (int i = 0; i < 32; ++i) { const int kk = 2 * i + (lane >> 5), k = k0 + kk; float gn = 1.f; if (g0) gn = (g1 && k >= 512) ? g1[k - 512] : g0[k];
        scr[kk * 33 + (lane & 31)] = W[(size_t)k * N + n0 + (lane & 31)] * gn; }
    asm volatile("s_waitcnt lgkmcnt(0)" ::: "memory");
    const int c = lane & 7;
#pragma unroll
    for (int j = 0; j < 4; ++j) { const int n = (lane >> 3) + 8 * j; const LAS float* s = scr + (8 * c) * 33 + n;
        u32x4 o; o.x = pk2(s[0 * 33], s[1 * 33]); o.y = pk2(s[2 * 33], s[3 * 33]); o.z = pk2(s[4 * 33], s[5 * 33]); o.w = pk2(s[6 * 33], s[7 * 33]);
        *(u32x4*)(WT + (size_t)(drow0 + n) * ldk + k0 + 8 * c) = o; }
    asm volatile("s_waitcnt lgkmcnt(0)" ::: "memory");
}
__device__ __forceinline__ void rms_row_to_bf16(const float* xrow, const float* gain, bf16_t* orow, int lane) {
    const f32x4* xr = (const f32x4*)xrow + lane; const f32x4* gr = (const f32x4*)gain + lane;
    f32x4 v[4]; float s = 0.f;
#pragma unroll
    for (int j = 0; j < 4; ++j) { v[j] = xr[64 * j]; s += (v[j].x * v[j].x + v[j].y * v[j].y) + (v[j].z * v[j].z + v[j].w * v[j].w); }
    const float rstd = 1.f / sqrtf(wave_sum(s) * (1.f / 1024.f) + EPS);
    unsigned long long* o8 = (unsigned long long*)orow + lane;
#pragma unroll
    for (int j = 0; j < 4; ++j) { const f32x4 g = gr[64 * j]; o8[64 * j] = (unsigned long long)pk2(v[j].x * rstd * g.x, v[j].y * rstd * g.y) | ((unsigned long long)pk2(v[j].z * rstd * g.z, v[j].w * rstd * g.w) << 32); }
}
__device__ __forceinline__ void p0_prologue(Frame& F) {
    LAS float* scr = (LAS float*)(F.lds + F.wave * 16384);
    const int gw = F.vcu * NWAVES + F.wave, NGW = F.G * NWAVES, lane = F.lane;
    constexpr int N_IN = 16 * 49, N_QUP = 12 * 24, N_KVUP = 4 * 32, N_GLU = 8 * 16, N_SQ = 16 * 32, N_GU1 = 16 * 8, N_D1 = 4 * 32;
    constexpr int NITEMS = N_IN + N_QUP + N_KVUP + N_GLU + 5 * N_SQ + 64 * N_GU1 + 32 * N_D1;
    for (int it = gw; it < NITEMS; it += NGW) {
        int r = it;
        if (r < N_IN) { tr_item(F.f(I_WIN), DIN, F.wt(WT_IN), 1024, 64 * (r / 49), 32 * (r % 49), 32 * (r % 49), nullptr, nullptr, scr, lane); continue; } r -= N_IN;
        if (r < N_QUP) { tr_item(F.f(I_WQUP), 768, F.wt(WT_QUP), 768, 64 * (r / 24), 32 * (r % 24), 32 * (r % 24), F.f(I_GQ), nullptr, scr, lane); continue; } r -= N_QUP;
        if (r < N_KVUP) { tr_item(F.f(I_WKVUP), 1024, F.wt(WT_KVUP), 256, 64 * (r / 32), 32 * (r % 32), 32 * (r % 32), F.f(I_GKV), nullptr, scr, lane); continue; } r -= N_KVUP;
        if (r < N_GLU) { tr_item(F.f(I_WGLU), 512, F.wt(WT_GLU), 512, 64 * (r / 16), 32 * (r % 16), 32 * (r % 16), nullptr, nullptr, scr, lane); continue; } r -= N_GLU;
        if (r < 5 * N_SQ) { const int w = r / N_SQ, q = r % N_SQ; const int k0 = 64 * (q / 32), n0 = 32 * (q % 32);
            if (w == 0) tr_item(F.f(I_WOUT), 1024, F.wt(WT_OUT), 1024, k0, n0, n0, F.f(I_GSSM), F.f(I_GMLA), scr, lane);
            else if (w == 1) tr_item(F.f(I_XWQ), 1024, F.wt(WT_XQ), 1024, k0, n0, n0, F.f(I_GX), nullptr, scr, lane);
            else if (w == 2) tr_item(F.f(I_XWK), 1024, F.wt(WT_XK), 1024, k0, n0, n0, nullptr, nullptr, scr, lane);
            else if (w == 3) tr_item(F.f(I_XWV), 1024, F.wt(WT_XV), 1024, k0, n0, n0, nullptr, nullptr, scr, lane);
            else tr_item(F.f(I_XWO), 1024, F.wt(WT_XO), 1024, k0, n0, n0, nullptr, nullptr, scr, lane);
            continue; } r -= 5 * N_SQ;
        if (r < 64 * N_GU1) { const int mi = r / N_GU1, q = r % N_GU1, e = mi >> 1, up = mi & 1; const int k0 = 64 * (q / 8), n0 = 32 * (q % 8);
            const float* W = F.f(up ? I_WUP : I_WGATE) + (size_t)e * 1024 * 256;
            tr_item(W, 256, F.wt(WT_GU) + (size_t)e * 512 * 1024, 1024, k0, n0, (n0 >> 7) * 256 + up * 128 + (n0 & 127), nullptr, nullptr, scr, lane); continue; } r -= 64 * N_GU1;
        { const int e = r / N_D1, q = r % N_D1; const int k0 = 64 * (q / 32), n0 = 32 * (q % 32);
            tr_item(F.f(I_WDOWN) + (size_t)e * 256 * 1024, 1024, F.wt(WT_D) + (size_t)e * 1024 * 256, 256, k0, n0, n0, nullptr, nullptr, scr, lane); }
    }
    { u32x4* p = (u32x4*)(F.wt(WT_IN) + (size_t)DIN * 1024); const int n16 = (ZP - DIN) * 1024 * 2 / 16; const int gt = gw * 64 + lane;
        for (int i = gt; i < n16; i += NGW * 64) p[i] = (u32x4){0u, 0u, 0u, 0u}; }
    bf16_t* XN = (bf16_t*)(F.ws + WS_A); bf16_t* MEMN = (bf16_t*)(F.ws + WS_MEMN);
    for (int m = gw; m < T + 1024; m += NGW) {
        if (m < T) rms_row_to_bf16(F.f(I_X) + (size_t)m * 1024, F.f(I_GMIX), XN + (size_t)m * 1024, lane);
        else rms_row_to_bf16(F.f(I_MEM) + (size_t)(m - T) * 1024, F.f(I_GMEM), MEMN + (size_t)(m - T) * 1024, lane);
    }
    { f32x2* rope = (f32x2*)(F.ws + WS_ROPE); const int* pos = (const int*)F.in[I_POS]; const int gt = gw * 64 + lane;
        for (int i = gt; i < T * 16; i += NGW * 64) { const int t = i >> 4, k = i & 15;
            const float inv = powf(10000.f, -(float)k / 16.f); const float ang = (float)pos[t] * inv;
            rope[i] = (f32x2){(float)cos((double)ang), (float)sin((double)ang)}; } }
    { unsigned char* tab = F.ws + WS_TAB; f32x2* abar = (f32x2*)(tab + TAB_ABAR); f32x2* a256 = (f32x2*)(tab + TAB_A256);
        bf16_t* BBT = (bf16_t*)(tab + TAB_BBT); bf16_t* CCT = (bf16_t*)(tab + TAB_CCT); bf16_t* WRH = (bf16_t*)(tab + TAB_WRH); bf16_t* WRL = (bf16_t*)(tab + TAB_WRL);
        const int gt = gw * 64 + lane;
        if (gt < 2048) { const int g = gt >> 6, p = gt & 63;
            const double lre = fmin((double)F.f(I_LRE)[gt], -1e-4), lim = (double)F.f(I_LIM)[gt], dt = exp((double)F.f(I_LDT)[g]);
            const double zr = lre * dt, zi = lim * dt; const double er = exp(zr); const double ar = er * cos(zi), ai = er * sin(zi);
            abar[gt] = (f32x2){(float)ar, (float)ai};
            const double e2 = exp(256.0 * zr); a256[gt] = (f32x2){(float)(e2 * cos(256.0 * zi)), (float)(e2 * sin(256.0 * zi))};
            const double den = lre * lre + lim * lim; const double cr = ((ar - 1.0) * lre + ai * lim) / den, ci = (ai * lre - (ar - 1.0) * lim) / den;
            const int blk = 2 * (p >> 5), j = p & 31;
            for (int h = 0; h < 16; ++h) { const double br = (double)F.f(I_BRE)[(size_t)gt * 16 + h], bi = (double)F.f(I_BIM)[(size_t)gt * 16 + h];
                BBT[(size_t)(g * 128 + blk * 32 + j) * 16 + h] = (bf16_t)f2bf((float)(cr * br - ci * bi));
                BBT[(size_t)(g * 128 + (blk + 1) * 32 + j) * 16 + h] = (bf16_t)f2bf((float)(cr * bi + ci * br)); }
            for (int h = 0; h < 32; ++h) { float vr = 0.f, vi = 0.f;
                if (h < 16) { vr = F.f(I_CRE)[(size_t)(g * 16 + h) * 64 + p]; vi = -F.f(I_CIM)[(size_t)(g * 16 + h) * 64 + p]; }
                CCT[(size_t)(g * 32 + h) * 128 + blk * 32 + j] = (bf16_t)f2bf(vr); CCT[(size_t)(g * 32 + h) * 128 + (blk + 1) * 32 + j] = (bf16_t)f2bf(vi); } }
        for (int i = gt; i < 64 * 1024; i += NGW * 64) { const int n = i >> 10, k = i & 1023; float w = 0.f;
            if (n < 4) w = F.f(I_WGRP)[(size_t)k * 4 + n]; else if (n < 36) w = F.f(I_WEXP)[(size_t)k * 32 + (n - 4)];
            const unsigned hb = f2bf(w); WRH[i] = (bf16_t)hb; WRL[i] = (bf16_t)f2bf(w - bf2f((unsigned short)hb)); } }
}

__device__ __forceinline__ void router_phase(Frame& F) {
    const int lane = F.lane, w = F.wave, r32 = lane & 31, hi = lane >> 5;
    for (int tb = F.vcu * 64; tb < T; tb += F.G * 64) {
    const float* x2 = F.out; const float* g3 = F.f(I_GMOE);
    bf16_t* XN3 = (bf16_t*)(F.ws + WS_Z);
    const bf16_t* WRH = (const bf16_t*)(F.ws + WS_TAB + TAB_WRH); const bf16_t* WRL = (const bf16_t*)(F.ws + WS_TAB + TAB_WRL);
    LAS float* part = (LAS float*)F.lds;
    LAS float* ssp = (LAS float*)(F.lds + 81920);
    f32x16 acc[2][2]; acc[0][0] = f32x16{}; acc[0][1] = f32x16{}; acc[1][0] = f32x16{}; acc[1][1] = f32x16{};
    float ss0 = 0.f, ss1 = 0.f;
#pragma unroll 2
    for (int s = 0; s < 8; ++s) { const int k = w * 128 + s * 16 + hi * 8;
        const f32x4 ga = *(const f32x4*)(g3 + k), gb = *(const f32x4*)(g3 + k + 4);
        bf16x8 wh[2], wl[2];
#pragma unroll
        for (int nb = 0; nb < 2; ++nb) { wh[nb] = *(const bf16x8*)(WRH + (size_t)(nb * 32 + r32) * 1024 + k); wl[nb] = *(const bf16x8*)(WRL + (size_t)(nb * 32 + r32) * 1024 + k); }
#pragma unroll
        for (int tq = 0; tq < 2; ++tq) { const size_t tok = (size_t)tb + tq * 32 + r32;
            const f32x4 xa = *(const f32x4*)(x2 + tok * 1024 + k), xb = *(const f32x4*)(x2 + tok * 1024 + k + 4);
            const float sq = (xa[0] * xa[0] + xa[1] * xa[1]) + (xa[2] * xa[2] + xa[3] * xa[3]) + (xb[0] * xb[0] + xb[1] * xb[1]) + (xb[2] * xb[2] + xb[3] * xb[3]);
            if (tq == 0) ss0 += sq; else ss1 += sq;
            const f32x4 va = xa * ga, vb = xb * gb;
            u32x4 h; h.x = pk2(va[0], va[1]); h.y = pk2(va[2], va[3]); h.z = pk2(vb[0], vb[1]); h.w = pk2(vb[2], vb[3]);
            *(u32x4*)(XN3 + tok * 1024 + k) = h;
            u32x4 l; l.x = pk2(va[0] - bflo(h.x), va[1] - bfhi(h.x)); l.y = pk2(va[2] - bflo(h.y), va[3] - bfhi(h.y)); l.z = pk2(vb[0] - bflo(h.z), vb[1] - bfhi(h.z)); l.w = pk2(vb[2] - bflo(h.w), vb[3] - bfhi(h.w));
            const bf16x8 bh = __builtin_bit_cast(bf16x8, h), bl = __builtin_bit_cast(bf16x8, l);
#pragma unroll
            for (int nb = 0; nb < 2; ++nb) {
                acc[tq][nb] = __builtin_amdgcn_mfma_f32_32x32x16_bf16(wh[nb], bh, acc[tq][nb], 0, 0, 0);
                acc[tq][nb] = __builtin_amdgcn_mfma_f32_32x32x16_bf16(wh[nb], bl, acc[tq][nb], 0, 0, 0);
                acc[tq][nb] = __builtin_amdgcn_mfma_f32_32x32x16_bf16(wl[nb], bh, acc[tq][nb], 0, 0, 0); } } }
#pragma unroll
    for (int tq = 0; tq < 2; ++tq) {
#pragma unroll
        for (int r = 0; r < 16; ++r) { const int n = (r & 3) + 8 * (r >> 2) + 4 * hi; part[(w * 64 + tq * 32 + r32) * 40 + n] = acc[tq][0][r]; }
        if (hi == 0) {
#pragma unroll
            for (int r = 0; r < 4; ++r) part[(w * 64 + tq * 32 + r32) * 40 + 32 + r] = acc[tq][1][r]; }
    }
    ss0 += __shfl_xor(ss0, 32); ss1 += __shfl_xor(ss1, 32);
    if (hi == 0) { ssp[w * 64 + r32] = ss0; ssp[w * 64 + 32 + r32] = ss1; }
    asm volatile("s_waitcnt lgkmcnt(0)" ::: "memory");
    __syncthreads();
    if (w == 0) {
        const int tok = tb + lane;
        float ss = 0.f;
#pragma unroll
        for (int k = 0; k < 8; ++k) ss += ssp[k * 64 + lane];
        const float rstd = 1.f / sqrtf(ss * (1.f / 1024.f) + EPS);
        float gl[4];
#pragma unroll
        for (int n = 0; n < 4; ++n) { float a = 0.f;
#pragma unroll
            for (int k = 0; k < 8; ++k) a += part[(k * 64 + lane) * 40 + n];
            gl[n] = a * rstd + F.f(I_BGRP)[n]; }
        int gi = 0; float gm = gl[0];
#pragma unroll
        for (int n = 1; n < 4; ++n) if (gl[n] > gm) { gm = gl[n]; gi = n; }
        float gsum = 0.f;
#pragma unroll
        for (int n = 0; n < 4; ++n) gsum += __expf(gl[n] - gm);
        const float gw_ = 1.f / gsum;
        float el[8];
#pragma unroll
        for (int j = 0; j < 8; ++j) { float a = 0.f;
#pragma unroll
            for (int k = 0; k < 8; ++k) a += part[(k * 64 + lane) * 40 + 4 + gi * 8 + j];
            el[j] = a * rstd + F.f(I_BEXP)[gi * 8 + j]; }
        int i0 = 0; float v0 = el[0];
#pragma unroll
        for (int j = 1; j < 8; ++j) if (el[j] > v0) { v0 = el[j]; i0 = j; }
        int i1 = -1; float v1 = -3.0e38f;
#pragma unroll
        for (int j = 0; j < 8; ++j) if (j != i0 && el[j] > v1) { v1 = el[j]; i1 = j; }
        const float w0 = 1.f / (1.f + __expf(v1 - v0)), w1 = 1.f - w0;
        const int e0 = gi * 8 + i0, e1 = gi * 8 + i1;
        unsigned* cnt = (unsigned*)(F.ws + WS_CTL) + CW_CNT;
        int pos0 = 0, pos1 = 0;
        const unsigned long long lt = (1ull << lane) - 1ull;
        for (int e = 0; e < NEXP; ++e) {
            const unsigned long long m0 = __ballot(e0 == e), m1 = __ballot(e1 == e);
            const int c0 = __popcll(m0), c1 = __popcll(m1);
            if (c0 + c1 == 0) continue;
            unsigned base = 0; if (lane == 0) base = atomicAdd(cnt + e, (unsigned)(c0 + c1));
            base = __builtin_amdgcn_readfirstlane(base);
            if (e0 == e) pos0 = (int)base + __popcll(m0 & lt);
            if (e1 == e) pos1 = (int)base + c0 + __popcll(m1 & lt);
        }
        int* list = (int*)(F.ws + WS_LIST); int* listd = (int*)(F.ws + WS_LISTD); float* listw = (float*)(F.ws + WS_LISTW);
        list[e0 * LCAP + pos0] = tok; listd[e0 * LCAP + pos0] = tok * 2; listw[e0 * LCAP + pos0] = w0 * gw_;
        list[e1 * LCAP + pos1] = tok; listd[e1 * LCAP + pos1] = tok * 2 + 1; listw[e1 * LCAP + pos1] = w1 * gw_;
        float* rstd3 = (float*)(F.ws + WS_TOKI); rstd3[tok] = rstd;
        int* tinfo = (int*)(F.ws + WS_TOKI + 65536); tinfo[tok * 4 + 0] = e0; tinfo[tok * 4 + 1] = e1; tinfo[tok * 4 + 2] = pos0; tinfo[tok * 4 + 3] = pos1;
        float* tokw = (float*)(F.ws + WS_TOKI + 65536 + 262144); tokw[tok * 2] = w0 * gw_; tokw[tok * 2 + 1] = w1 * gw_;
    }
    __syncthreads();
    }
}

__device__ __forceinline__ void final_phase(Frame& F) {
    const int gw = F.vcu * NWAVES + F.wave, NGW = F.G * NWAVES, lane = F.lane;
    const bf16_t* ymoe = (const bf16_t*)(F.ws + WS_YMOE); const f32x4* gr = (const f32x4*)F.f(I_GFIN) + lane;
    for (int m = gw; m < T; m += NGW) {
        f32x4* xr = (f32x4*)(F.out + (size_t)m * 1024) + lane;
        const u32x2* y0 = (const u32x2*)(ymoe + (size_t)(2 * m) * 1024) + lane; const u32x2* y1 = (const u32x2*)(ymoe + (size_t)(2 * m + 1) * 1024) + lane;
        f32x4 v[4]; float s = 0.f;
#pragma unroll
        for (int j = 0; j < 4; ++j) { v[j] = xr[64 * j]; const u32x2 a = y0[64 * j], b = y1[64 * j];
            v[j].x += bflo(a.x) + bflo(b.x); v[j].y += bfhi(a.x) + bfhi(b.x); v[j].z += bflo(a.y) + bflo(b.y); v[j].w += bfhi(a.y) + bfhi(b.y);
            s += (v[j].x * v[j].x + v[j].y * v[j].y) + (v[j].z * v[j].z + v[j].w * v[j].w); }
        const float rstd = 1.f / sqrtf(wave_sum(s) * (1.f / 1024.f) + EPS);
#pragma unroll
        for (int j = 0; j < 4; ++j) xr[64 * j] = v[j] * rstd * gr[64 * j];
    }
}

#if DEBUG_HYBRID
namespace nv {
template <class E>
__global__ __launch_bounds__(256) void gemm(const bf16_t* A, int lda, const bf16_t* Bt, int ldb, int K, E e) {
    __shared__ float As[16][65], Bs[16][65];
    const int tx = threadIdx.x & 15, ty = threadIdx.x >> 4, m0 = blockIdx.y * 64, n0 = blockIdx.x * 64;
    float acc[4][4] = {};
    for (int k0 = 0; k0 < K; k0 += 16) {
        for (int i = 0; i < 4; ++i) { const int idx = threadIdx.x + 256 * i, r = idx >> 4, kk = idx & 15;
            As[kk][r] = bf2f(A[(size_t)(m0 + r) * lda + k0 + kk]); Bs[kk][r] = bf2f(Bt[(size_t)(n0 + r) * ldb + k0 + kk]); }
        __syncthreads();
        for (int kk = 0; kk < 16; ++kk) { float a[4], b[4];
            for (int i = 0; i < 4; ++i) { a[i] = As[kk][ty + 16 * i]; b[i] = Bs[kk][tx + 16 * i]; }
            for (int i = 0; i < 4; ++i) for (int j = 0; j < 4; ++j) acc[i][j] += a[i] * b[j]; }
        __syncthreads();
    }
    for (int i = 0; i < 4; ++i) e(m0 + ty + 16 * i, n0, tx, acc[i]);
}
struct EZ { bf16_t* z; ss_t* ssq; ss_t* sskv; bf16_t* kpe; const f32x2* rope;
    __device__ void operator()(int row, int n0, int tx, const float (&v)[4]) const {
        if (n0 < 1536) { float s = 0.f; for (int j = 0; j < 4; ++j) { z[(size_t)row * ZP + n0 + tx + 16 * j] = (bf16_t)f2bf(v[j]); s += v[j] * v[j]; }
            if (n0 >= 512 && n0 < 1280) ss_add(ssq + row, s); else if (n0 >= 1280) ss_add(sskv + row, s); }
        else if (n0 == 1536) { const f32x2 cs = rope[(size_t)row * 16 + tx];
            kpe[(size_t)row * 32 + tx] = (bf16_t)f2bf(v[0] * cs.x - v[1] * cs.y); kpe[(size_t)row * 32 + 16 + tx] = (bf16_t)f2bf(v[0] * cs.y + v[1] * cs.x); } } };
struct EStore { bf16_t* O; int ldc;
    __device__ void operator()(int row, int n0, int tx, const float (&v)[4]) const { for (int j = 0; j < 4; ++j) O[(size_t)row * ldc + n0 + tx + 16 * j] = (bf16_t)f2bf(v[j]); } };
struct EVXT { bf16_t* O;
    __device__ void operator()(int row, int n0, int tx, const float (&v)[4]) const { for (int j = 0; j < 4; ++j) { const int n = n0 + tx + 16 * j; O[(size_t)(n >> 8) * 262144 + (size_t)row * 256 + (n & 255)] = (bf16_t)f2bf(v[j]); } } };
struct EQ { bf16_t* q; const ss_t* ssq; const f32x2* rope;
    __device__ void operator()(int row, int n0, int tx, const float (&v)[4]) const {
        const float rs = 1.f / sqrtf(ss_get(ssq + row) * (1.f / 768.f) + EPS) * QS; float o[4];
        for (int j = 0; j < 4; ++j) o[j] = v[j] * rs;
        for (int hh = 0; hh < 2; ++hh) { const int g32 = n0 / 32 + hh; if (g32 % 3 == 2) { const f32x2 cs = rope[(size_t)row * 16 + tx]; const float a = o[2 * hh], b = o[2 * hh + 1];
            o[2 * hh] = a * cs.x - b * cs.y; o[2 * hh + 1] = a * cs.y + b * cs.x; } }
        for (int j = 0; j < 4; ++j) q[(size_t)row * 768 + n0 + tx + 16 * j] = (bf16_t)f2bf(o[j]); } };
struct EKV { bf16_t* kv; const ss_t* sskv;
    __device__ void operator()(int row, int n0, int tx, const float (&v)[4]) const { const float rs = 1.f / sqrtf(ss_get(sskv + row) * (1.f / 256.f) + EPS);
        for (int j = 0; j < 4; ++j) kv[(size_t)row * 1024 + n0 + tx + 16 * j] = (bf16_t)f2bf(v[j] * rs); } };
struct EGLU { const bf16_t* yg; const float* bias; bf16_t* y; ss_t* ss;
    __device__ void operator()(int row, int n0, int tx, const float (&v)[4]) const { float s = 0.f;
        for (int j = 0; j < 4; ++j) { const int c = n0 + tx + 16 * j; const float o = bf2f(yg[(size_t)row * 512 + c]) * sigmoidf_(v[j] + bias[c]); s += o * o; y[(size_t)row * 1024 + c] = (bf16_t)f2bf(o); }
        ss_add(ss + row, s); } };
struct EOutA { const float* base; float* out; const ss_t* ss;
    __device__ void operator()(int row, int n0, int tx, const float (&v)[4]) const { const float rs = 1.f / sqrtf(ss_get(ss + row) * (1.f / 512.f) + EPS);
        for (int j = 0; j < 4; ++j) { const size_t o = (size_t)row * 1024 + n0 + tx + 16 * j; out[o] = base[o] + v[j] * rs; } } };
struct EOutB { float* out; bf16_t* xb; const ss_t* ss; ss_t* ssx;
    __device__ void operator()(int row, int n0, int tx, const float (&v)[4]) const { const float rs = 1.f / sqrtf(ss_get(ss + row) * (1.f / 512.f) + EPS); float s = 0.f;
        for (int j = 0; j < 4; ++j) { const size_t o = (size_t)row * 1024 + n0 + tx + 16 * j; const float x1 = out[o] + v[j] * rs; out[o] = x1; xb[o] = (bf16_t)f2bf(x1); s += x1 * x1; }
        ss_add(ssx + row, s); } };
struct EXQ { bf16_t* O; const ss_t* ss;
    __device__ void operator()(int row, int n0, int tx, const float (&v)[4]) const { const float rs = 1.f / sqrtf(ss_get(ss + row) * (1.f / 1024.f) + EPS) * XS;
        for (int j = 0; j < 4; ++j) O[(size_t)row * 1024 + n0 + tx + 16 * j] = (bf16_t)f2bf(v[j] * rs); } };
struct EAdd { float* out;
    __device__ void operator()(int row, int n0, int tx, const float (&v)[4]) const { for (int j = 0; j < 4; ++j) out[(size_t)row * 1024 + n0 + tx + 16 * j] += v[j]; } };

__global__ __launch_bounds__(64) void ssm_a(const bf16_t* z, const unsigned char* tab, float* Sc) {
    const int it = blockIdx.x, lane = threadIdx.x, c = it & 15, g = (it >> 4) & 31, b = it >> 9, p = lane;
    const f32x2 a = ((const f32x2*)(tab + TAB_ABAR))[g * 64 + p]; const bf16_t* BBT = (const bf16_t*)(tab + TAB_BBT);
    const int blk = 2 * (p >> 5), j = p & 31; float br[16], bi[16];
    for (int h = 0; h < 16; ++h) { br[h] = bf2f(BBT[(size_t)(g * 128 + blk * 32 + j) * 16 + h]); bi[h] = bf2f(BBT[(size_t)(g * 128 + (blk + 1) * 32 + j) * 16 + h]); }
    float xr = 0.f, xi = 0.f;
    for (int t = 0; t < 256; ++t) { const bf16_t* u = z + ((size_t)b * SEQ + c * 256 + t) * ZP + g * 16; float sr = 0.f, si = 0.f;
        for (int h = 0; h < 16; ++h) { const float uu = bf2f(u[h]); sr += br[h] * uu; si += bi[h] * uu; }
        const float nr = a.x * xr - a.y * xi + sr, ni = a.x * xi + a.y * xr + si; xr = nr; xi = ni; }
    Sc[(size_t)it * 128 + blk * 32 + j] = xr; Sc[(size_t)it * 128 + (blk + 1) * 32 + j] = xi;
}
__global__ __launch_bounds__(64) void ssm_c(const bf16_t* z, const unsigned char* tab, const float* dskip, bf16_t* yg) {
    const int g = blockIdx.x & 31, b = blockIdx.x >> 5, p = threadIdx.x;
    const f32x2 a = ((const f32x2*)(tab + TAB_ABAR))[g * 64 + p]; const bf16_t* BBT = (const bf16_t*)(tab + TAB_BBT); const bf16_t* CCT = (const bf16_t*)(tab + TAB_CCT);
    const int blk = 2 * (p >> 5), j = p & 31; float br[16], bi[16], cr[16], ci[16];
    for (int h = 0; h < 16; ++h) { br[h] = bf2f(BBT[(size_t)(g * 128 + blk * 32 + j) * 16 + h]); bi[h] = bf2f(BBT[(size_t)(g * 128 + (blk + 1) * 32 + j) * 16 + h]);
        cr[h] = bf2f(CCT[(size_t)(g * 32 + h) * 128 + blk * 32 + j]); ci[h] = bf2f(CCT[(size_t)(g * 32 + h) * 128 + (blk + 1) * 32 + j]); }
    float xr = 0.f, xi = 0.f;
    for (int t = 0; t < SEQ; ++t) { const size_t tok = (size_t)b * SEQ + t; const bf16_t* u = z + tok * ZP + g * 16; float sr = 0.f, si = 0.f, uu[16];
        for (int h = 0; h < 16; ++h) { uu[h] = bf2f(u[h]); sr += br[h] * uu[h]; si += bi[h] * uu[h]; }
        const float nr = a.x * xr - a.y * xi + sr, ni = a.x * xi + a.y * xr + si; xr = nr; xi = ni;
        for (int h = 0; h < 16; ++h) { const float yv = wave_sum(cr[h] * xr + ci[h] * xi);
            if (p == h) yg[tok * 512 + g * 16 + h] = (bf16_t)f2bf(gelu_tanh(yv + dskip[g * 16 + h] * uu[h])); } }
}
__global__ __launch_bounds__(64) void mla_attn(const bf16_t* q, const bf16_t* kv, const bf16_t* kpe, bf16_t* y, ss_t* ssm) {
    __shared__ float Ks[64][97], Vs[64][65];
    const int qc = blockIdx.x & 63, h = (blockIdx.x >> 6) & 7, b = blockIdx.x >> 9, tq = threadIdx.x;
    const size_t row = (size_t)b * SEQ + qc * 64 + tq;
    float qv[96], o[64]; for (int d = 0; d < 96; ++d) qv[d] = bf2f(q[row * 768 + h * 96 + d]); for (int d = 0; d < 64; ++d) o[d] = 0.f;
    float m = -1e30f, l = 0.f;
    for (int kt = 0; kt <= qc; ++kt) {
        __syncthreads();
        for (int i = threadIdx.x; i < 64 * 96; i += 64) { const int k = i / 96, d = i % 96; const size_t kr = (size_t)b * SEQ + kt * 64 + k;
            Ks[k][d] = d < 64 ? bf2f(kv[kr * 1024 + h * 128 + d]) : bf2f(kpe[kr * 32 + d - 64]); }
        for (int i = threadIdx.x; i < 64 * 64; i += 64) { const int k = i / 64, d = i % 64; Vs[k][d] = bf2f(kv[((size_t)b * SEQ + kt * 64 + k) * 1024 + h * 128 + 64 + d]); }
        __syncthreads();
        for (int k = 0; k < 64; ++k) { float s = 0.f; for (int d = 0; d < 96; ++d) s += qv[d] * Ks[k][d];
            const float mn = fmaxf(m, s), al = exp2f(m - mn), pp = exp2f(s - mn); l = l * al + pp; for (int d = 0; d < 64; ++d) o[d] = o[d] * al + pp * Vs[k][d]; m = mn; }
    }
    float s2 = 0.f; for (int d = 0; d < 64; ++d) { const float v = o[d] / l; s2 += v * v; y[row * 1024 + 512 + h * 64 + d] = (bf16_t)f2bf(v); }
    ss_add(ssm + row, s2);
}
__global__ __launch_bounds__(256) void xattn(const bf16_t* QX, const bf16_t* KX, const bf16_t* VXT, bf16_t* OX) {
    __shared__ float qs[256], ps[256], red[256];
    const int tok = blockIdx.x >> 2, h = blockIdx.x & 3, b = tok / SEQ, t = threadIdx.x;
    qs[t] = bf2f(QX[(size_t)tok * 1024 + h * 256 + t]); __syncthreads();
    float s = 0.f; const bf16_t* kr = KX + (size_t)(b * 256 + t) * 1024 + h * 256; for (int d = 0; d < 256; ++d) s += qs[d] * bf2f(kr[d]);
    red[t] = s; __syncthreads(); for (int o = 128; o > 0; o >>= 1) { if (t < o) red[t] = fmaxf(red[t], red[t + o]); __syncthreads(); }
    const float mx = red[0]; __syncthreads();
    const float p = exp2f(s - mx); ps[t] = bf2f((unsigned short)f2bf(p)); red[t] = p; __syncthreads(); for (int o = 128; o > 0; o >>= 1) { if (t < o) red[t] += red[t + o]; __syncthreads(); }
    const float l = red[0];
    float acc = 0.f; const bf16_t* vr = VXT + (size_t)b * 262144 + (size_t)(h * 256 + t) * 256; for (int k = 0; k < 256; ++k) acc += ps[k] * bf2f(vr[k]);
    OX[(size_t)tok * 1024 + h * 256 + t] = (bf16_t)f2bf(acc / l);
}
__global__ __launch_bounds__(256) void router(const float* x2, const float* g3, const float* wg, const float* bg, const float* we, const float* be, unsigned char* ws) {
    __shared__ float red[256]; __shared__ float lg[36];
    const int tok = blockIdx.x, t = threadIdx.x; float xv[4], hv[4]; float s = 0.f;
    for (int i = 0; i < 4; ++i) { xv[i] = x2[(size_t)tok * 1024 + t + 256 * i]; s += xv[i] * xv[i]; hv[i] = xv[i] * g3[t + 256 * i]; }
    red[t] = s; __syncthreads(); for (int o = 128; o > 0; o >>= 1) { if (t < o) red[t] += red[t + o]; __syncthreads(); }
    const float rstd = 1.f / sqrtf(red[0] * (1.f / 1024.f) + EPS); __syncthreads();
    bf16_t* XN3 = (bf16_t*)(ws + WS_Z); for (int i = 0; i < 4; ++i) XN3[(size_t)tok * 1024 + t + 256 * i] = (bf16_t)f2bf(hv[i]);
    for (int n = 0; n < 36; ++n) { float a = 0.f; for (int i = 0; i < 4; ++i) { const int k = t + 256 * i; a += hv[i] * (n < 4 ? wg[(size_t)k * 4 + n] : we[(size_t)k * 32 + n - 4]); }
        red[t] = a; __syncthreads(); for (int o = 128; o > 0; o >>= 1) { if (t < o) red[t] += red[t + o]; __syncthreads(); } if (t == 0) lg[n] = red[0] * rstd; __syncthreads(); }
    if (t == 0) { float gl[4]; for (int n = 0; n < 4; ++n) gl[n] = lg[n] + bg[n]; int gi = 0; float gm = gl[0]; for (int n = 1; n < 4; ++n) if (gl[n] > gm) { gm = gl[n]; gi = n; }
        float gs = 0.f; for (int n = 0; n < 4; ++n) gs += expf(gl[n] - gm); const float gw = 1.f / gs;
        float el[8]; for (int j = 0; j < 8; ++j) el[j] = lg[4 + gi * 8 + j] + be[gi * 8 + j];
        int i0 = 0; float v0 = el[0]; for (int j = 1; j < 8; ++j) if (el[j] > v0) { v0 = el[j]; i0 = j; }
        int i1 = -1; float v1 = -3.0e38f; for (int j = 0; j < 8; ++j) if (j != i0 && el[j] > v1) { v1 = el[j]; i1 = j; }
        const float w0 = 1.f / (1.f + expf(v1 - v0)), w1 = 1.f - w0; const int e0 = gi * 8 + i0, e1 = gi * 8 + i1;
        unsigned* cnt = (unsigned*)(ws + WS_CTL) + CW_CNT; const int pos0 = (int)atomicAdd(cnt + e0, 1u), pos1 = (int)atomicAdd(cnt + e1, 1u);
        int* list = (int*)(ws + WS_LIST); int* listd = (int*)(ws + WS_LISTD); float* listw = (float*)(ws + WS_LISTW);
        list[e0 * LCAP + pos0] = tok; listd[e0 * LCAP + pos0] = tok * 2; listw[e0 * LCAP + pos0] = w0 * gw;
        list[e1 * LCAP + pos1] = tok; listd[e1 * LCAP + pos1] = tok * 2 + 1; listw[e1 * LCAP + pos1] = w1 * gw;
        ((float*)(ws + WS_TOKI))[tok] = rstd; int* ti = (int*)(ws + WS_TOKI + 65536); ti[tok * 4] = e0; ti[tok * 4 + 1] = e1; ti[tok * 4 + 2] = pos0; ti[tok * 4 + 3] = pos1;
        float* tw = (float*)(ws + WS_TOKI + 65536 + 262144); tw[tok * 2] = w0 * gw; tw[tok * 2 + 1] = w1 * gw; }
}
__global__ __launch_bounds__(256) void moe_slot(unsigned char* ws) {
    __shared__ float hs[1024], av[256];
    const int tok = blockIdx.x >> 1, k = blockIdx.x & 1, t = threadIdx.x;
    const int e = ((const int*)(ws + WS_TOKI + 65536))[tok * 4 + k]; const float w = ((const float*)(ws + WS_TOKI + 65536 + 262144))[tok * 2 + k]; const float rstd = ((const float*)(ws + WS_TOKI))[tok];
    const bf16_t* XN3 = (const bf16_t*)(ws + WS_Z); for (int i = 0; i < 4; ++i) hs[t + 256 * i] = bf2f(XN3[(size_t)tok * 1024 + t + 256 * i]); __syncthreads();
    const bf16_t* WG = (const bf16_t*)(ws + WS_WT) + WT_GU + (size_t)e * 512 * 1024; const bf16_t* WD = (const bf16_t*)(ws + WS_WT) + WT_D + (size_t)e * 1024 * 256;
    const bf16_t* gr = WG + (size_t)((t >> 7) * 256 + (t & 127)) * 1024; const bf16_t* ur = gr + (size_t)128 * 1024; float g = 0.f, u = 0.f;
    for (int d = 0; d < 1024; ++d) { g += hs[d] * bf2f(gr[d]); u += hs[d] * bf2f(ur[d]); }
    g *= rstd; u *= rstd; av[t] = bf2f((unsigned short)f2bf(g * sigmoidf_(g) * u)); __syncthreads();
    bf16_t* ymoe = (bf16_t*)(ws + WS_YMOE);
    for (int i = 0; i < 4; ++i) { const int d = t + 256 * i; const bf16_t* dr = WD + (size_t)d * 256; float a = 0.f; for (int f = 0; f < 256; ++f) a += av[f] * bf2f(dr[f]);
        ymoe[(size_t)(tok * 2 + k) * 1024 + d] = (bf16_t)f2bf(a * w); }
}
__global__ __launch_bounds__(256) void final_rows(float* out, const bf16_t* ymoe, const float* g) {
    __shared__ float red[256]; const int tok = blockIdx.x, t = threadIdx.x; float v[4]; float s = 0.f;
    for (int i = 0; i < 4; ++i) { const int c = t + 256 * i; v[i] = out[(size_t)tok * 1024 + c] + bf2f(ymoe[(size_t)(2 * tok) * 1024 + c]) + bf2f(ymoe[(size_t)(2 * tok + 1) * 1024 + c]); s += v[i] * v[i]; }
    red[t] = s; __syncthreads(); for (int o = 128; o > 0; o >>= 1) { if (t < o) red[t] += red[t + o]; __syncthreads(); }
    const float rstd = 1.f / sqrtf(red[0] * (1.f / 1024.f) + EPS);
    for (int i = 0; i < 4; ++i) { const int c = t + 256 * i; out[(size_t)tok * 1024 + c] = v[i] * rstd * g[c]; }
}
}
#endif

constexpr int NPHASE = 12;
__global__ void __launch_bounds__(NWAVES * 64, 2) mega_fwd(Args args) {
    extern __shared__ __attribute__((aligned(16))) unsigned char lds_raw[];
    Frame F;
    F.lds = (LAS unsigned char*)lds_raw; F.ws = args.ws; F.out = args.out; F.in = args.in;
    F.tid = threadIdx.x; F.lane = F.tid & 63; F.wave = __builtin_amdgcn_readfirstlane(F.tid >> 6);
    F.G = gridDim.x; { const int bx = blockIdx.x; F.vcu = (F.G % 8 == 0) ? (bx % 8) * (F.G / 8) + bx / 8 : bx; }
    volatile LAS unsigned* MISC = (volatile LAS unsigned*)(F.lds + MISC_OFF);
    for (int u = F.tid; u < (LDS_BYTES - LDSCTL_OFF) / 4; u += NWAVES * 64) ((LAS unsigned*)(F.lds + LDSCTL_OFF))[u] = 0u;
    __syncthreads();
    const int lo = args.ph_lo, hi = args.ph_hi;
    unsigned* ctl = (unsigned*)(F.ws + WS_CTL);
    XcdBarrier bar; bar.bar = ctl + CW_BAR; bar.x = 0; bar.st = nullptr;
    if (hi - lo > 1) bar = xcd_barrier_post(ctl + CW_BAR, MISC + 8);
#ifndef PHASE_ENABLE
#define PHASE_ENABLE 0xFFF
#endif
#define IN(k) (((PHASE_ENABLE >> (k)) & 1) && lo <= (k) && (k) < hi)
#define SEAM(k) do { if (IN(k) && IN((k) + 1)) xcd_barrier(bar); } while (0)
    unsigned char* ws = F.ws; const int c = (int)blockIdx.x, G = F.G;
#define XN ((bf16_t*)(ws + WS_A))
#define Y ((bf16_t*)(ws + WS_A))
#define OX ((bf16_t*)(ws + WS_A))
#define Z ((bf16_t*)(ws + WS_Z))
#define X1B ((bf16_t*)(ws + WS_Z))
#define XN3 ((bf16_t*)(ws + WS_Z))
#define QX ((bf16_t*)(ws + WS_QX))
#define H1 ((bf16_t*)(ws + WS_QX))
#define Q ((bf16_t*)(ws + WS_Q))
#define PB ((bf16_t*)(ws + WS_PB))
#define KV ((bf16_t*)(ws + WS_KV))
#define KPE ((bf16_t*)(ws + WS_KPE))
#define YG ((bf16_t*)(ws + WS_YG))
#define YMOE ((bf16_t*)(ws + WS_YMOE))
#define MEMN ((bf16_t*)(ws + WS_MEMN))
#define KX ((bf16_t*)(ws + WS_KX))
#define VXT ((bf16_t*)(ws + WS_VXT))
#define ROPE ((const f32x2*)(ws + WS_ROPE))
#define SC ((float*)(ws + WS_SC))
#define ABAR ((const f32x2*)(ws + WS_TAB + TAB_ABAR))
#define A256 ((const f32x2*)(ws + WS_TAB + TAB_A256))
#define BBT ((const bf16_t*)(ws + WS_TAB + TAB_BBT))
#define CCT ((const bf16_t*)(ws + WS_TAB + TAB_CCT))
#define SSQ (F.ctlf(CW_SSQ))
#define SSKV (F.ctlf(CW_SSKV))
#define SSMLA (F.ctlf(CW_SSMLA))
#define SSSSM (F.ctlf(CW_SSSSM))
#define SSX1 (F.ctlf(CW_SSX1))
#define LROW ((float*)(ws + WS_TOKI + 524288))

    if (IN(0)) { p0_prologue(F); SEAM(0); }

    if (IN(1)) {
        { pg8::ProbDense P{XN, F.wt(WT_IN), 1024, 1024, 1024, {}}; P.O.init(T / 256, ZP / 256, G, c);
          epi::EpiZ E{Z, SSQ, SSKV, KPE, ROPE}; pg8::gemm_phase<epi::EpiZ, pg8::ProbDense, true>(F.lds, P, E); }
        const int c2 = (c + 64) % G;
        { pg8::ProbDense P{MEMN, F.wt(WT_XK), 1024, 1024, 1024, {}}; P.O.init(4, 4, G, c2);
          epi::EpiStore E{KX, 1024}; pg8::gemm_phase<epi::EpiStore, pg8::ProbDense, true>(F.lds, P, E); }
        { pg8::ProbDense P{F.wt(WT_XV), MEMN, 1024, 1024, 1024, {}}; P.O.init(4, 4, G, c2 - 16);
          epi::EpiVXT E{VXT}; pg8::gemm_phase<epi::EpiVXT, pg8::ProbDense, true>(F.lds, P, E); }
        SEAM(1);
    }

    if (IN(2)) {
        for (int it = F.vcu * NWAVES + F.wave; it < 2048; it += G * NWAVES)
            ssm::item<false>(it, Z, ABAR, A256, BBT, CCT, F.f(I_SD), SC, YG, (LAS bf16_t*)(F.lds + F.wave * 16384), F.lane);
        __syncthreads();
        const int nq = (G * 3) / 4;
        if (c < nq) { pg8::ProbDense P{Z + 512, F.wt(WT_QUP), ZP, 768, 768, {}}; P.O.init(T / 256, 3, nq, c);
            epi::EpiQ E{Q, SSQ, ROPE}; pg8::gemm_phase<epi::EpiQ, pg8::ProbDense, true>(F.lds, P, E); }
        else { pg8::ProbDense P{Z + 1280, F.wt(WT_KVUP), ZP, 256, 256, {}}; P.O.init(T / 256, 4, G - nq, c - nq);
            epi::EpiKV E{KV, SSKV}; pg8::gemm_phase<epi::EpiKV, pg8::ProbDense, true>(F.lds, P, E); }
        SEAM(2);
    }

    if (IN(3)) {
#ifndef NO_SSMC
        for (int it = F.vcu * NWAVES + F.wave; it < 2048; it += G * NWAVES)
            ssm::item<true>(it, Z, ABAR, A256, BBT, CCT, F.f(I_SD), SC, YG, (LAS bf16_t*)(F.lds + F.wave * 16384), F.lane);
#endif
        __syncthreads();
#ifndef NO_MLA
        for (int v = F.vcu; v < 256; v += G) { const int bh = v >> 3, s = v & 7;
            mla::unit(bh >> 3, bh & 7, s, Q, KV, KPE, Y, SSMLA, (char*)lds_raw);
            mla::unit(bh >> 3, bh & 7, 15 - s, Q, KV, KPE, Y, SSMLA, (char*)lds_raw); }
#endif
        SEAM(3);
    }

    if (IN(4)) {
        { pg8::ProbDense P{YG, F.wt(WT_GLU), 512, 512, 512, {}}; P.O.init(T / 256, 2, G, c);
          epi::EpiGLU E{YG, F.f(I_BGLU), Y, SSSSM}; pg8::gemm_phase<epi::EpiGLU, pg8::ProbDense, true>(F.lds, P, E); }
        SEAM(4);
    }

    if (IN(5)) {
        pg8::GridOrder O; O.init(T / 256, 4, G, c);
        int pm, pn;
        for (int i = 0; O.get(i, pm, pn); ++i) {
            { pg8::ProbOne P{Y + (size_t)pm * 256 * 1024, F.wt(WT_OUT) + (size_t)pn * 256 * 1024, 1024, 1024, 512, pm, pn};
              epi::EpiOutA E{F.f(I_X), F.out, SSSSM}; pg8::gemm_phase<epi::EpiOutA, pg8::ProbOne, false>(F.lds, P, E); }
            { pg8::ProbOne P{Y + (size_t)pm * 256 * 1024 + 512, F.wt(WT_OUT) + (size_t)pn * 256 * 1024 + 512, 1024, 1024, 512, pm, pn};
              epi::EpiOutB E{F.out, X1B, SSMLA, SSX1}; pg8::gemm_phase<epi::EpiOutB, pg8::ProbOne, false>(F.lds, P, E); }
        }
        SEAM(5);
    }

    if (IN(6)) {
        pg8::GridOrder O; O.init(T / 256, 4, G, c);
        int pm, h;
        for (int i = 0; O.get(i, pm, h); ++i) { const int b = pm / 16;
            { pg8::ProbOne P{X1B + (size_t)pm * 256 * 1024, F.wt(WT_XQ) + (size_t)h * 256 * 1024, 1024, 1024, 1024, pm, h};
              epi::EpiXQ E{QX, SSX1}; pg8::gemm_phase<epi::EpiXQ, pg8::ProbOne, false>(F.lds, P, E); }
            cu_sync_global();
            { pg8::ProbOne P{QX + (size_t)pm * 256 * 1024 + h * 256, KX + (size_t)b * 256 * 1024 + h * 256, 1024, 1024, 256, pm, h};
              epi::EpiSoft E{PB, LROW}; pg8::gemm_phase<epi::EpiSoft, pg8::ProbOne, false>(F.lds, P, E); }
            cu_sync_global();
            { pg8::ProbOne P{PB + (size_t)pm * 256 * 1024 + h * 256, VXT + (size_t)b * 262144 + (size_t)h * 256 * 256, 1024, 256, 256, pm, h};
              epi::EpiPV E{OX, LROW}; pg8::gemm_phase<epi::EpiPV, pg8::ProbOne, false>(F.lds, P, E); }
        }
        SEAM(6);
    }

    if (IN(7)) {
        { pg8::ProbDense P{OX, F.wt(WT_XO), 1024, 1024, 1024, {}}; P.O.init(T / 256, 4, G, c);
          epi::EpiAdd E{F.out}; pg8::gemm_phase<epi::EpiAdd, pg8::ProbDense, true>(F.lds, P, E); }
        SEAM(7);
    }

    if (IN(8)) { router_phase(F); SEAM(8); }

    if (IN(9) || IN(10)) {
        LAS int* tmap = (LAS int*)(F.lds + TMAP_OFF); volatile LAS int* nt_l = (volatile LAS int*)(F.lds + TMAP_OFF + 1024);
        const unsigned* cnt = (const unsigned*)(ws + WS_CTL) + CW_CNT;
        if (F.tid == 0) { int j = 0; for (int e = 0; e < NEXP; ++e) { const int n = (int)__hip_atomic_load(cnt + e, RLX_AGENT); const int nr = (n + 255) >> 8; for (int r = 0; r < nr && j < 192; ++r) tmap[j++] = e | (r << 8); } nt_l[0] = j; }
        __syncthreads();
        moe::Ctx X{tmap, (int)nt_l[0], cnt, (const int*)(ws + WS_LIST), (const int*)(ws + WS_LISTD), (const float*)(ws + WS_LISTW), (const float*)(ws + WS_TOKI)};
        if (IN(9)) { moe::ProbGU P{XN3, F.wt(WT_GU), 1024, X, G, c}; moe::EpiGU E{H1, X}; pg8::gemm_phase<moe::EpiGU, moe::ProbGU, true>(F.lds, P, E); SEAM(9); }
        if (IN(10)) { int nk4 = 4; asm volatile("" : "+s"(nk4)); moe::ProbD P{H1, F.wt(WT_D), 256, X, G, c, nk4}; moe::EpiD E{YMOE, X}; pg8::gemm_phase<moe::EpiD, moe::ProbD, true>(F.lds, P, E); SEAM(10); }
    }

    if (IN(11)) { final_phase(F); }
#undef IN
#undef XN
#undef Y
#undef OX
#undef Z
#undef X1B
#undef XN3
#undef QX
#undef H1
#undef Q
#undef PB
#undef KV
#undef KPE
#undef YG
#undef YMOE
#undef MEMN
#undef KX
#undef VXT
#undef ROPE
#undef SC
#undef ABAR
#undef A256
#undef BBT
#undef CCT
#undef SSQ
#undef SSKV
#undef SSMLA
#undef SSSSM
#undef SSX1
#undef LROW
#undef SEAM
}

#ifndef FASTMASK
#define FASTMASK 0xFFF
#endif
extern "C" void kernel_launch(void* const* d_in, const int* in_sizes, int n_in, void* d_out, int out_size, void* d_ws, size_t ws_size, hipStream_t stream) {
    static int grid = 0;
    if (grid == 0) {
        if (n_in != 37 || in_sizes[0] != T * DM || out_size != T * DM || ws_size < WS_END) { fprintf(stderr, "kernel_launch: unexpected shapes (n_in %d, in0 %d, out %d, ws %zu)\n", n_in, n_in > 0 ? in_sizes[0] : -1, out_size, ws_size); grid = -1; return; }
        int dev = 0, cus = 0, per_cu = 0;
        if (hipGetDevice(&dev) != hipSuccess || hipDeviceGetAttribute(&cus, hipDeviceAttributeMultiprocessorCount, dev) != hipSuccess) { grid = -1; return; }
        if (hipFuncSetAttribute((const void*)mega_fwd, hipFuncAttributeMaxDynamicSharedMemorySize, LDS_BYTES) != hipSuccess) { fprintf(stderr, "kernel_launch: hipFuncSetAttribute failed\n"); grid = -1; return; }
        if (hipOccupancyMaxActiveBlocksPerMultiprocessor(&per_cu, (const void*)mega_fwd, NWAVES * 64, LDS_BYTES) != hipSuccess || per_cu < 1) fprintf(stderr, "kernel_launch: occupancy query says %d\n", per_cu);
        (void)hipGetLastError();
        grid = cus;
    }
    if (grid < 0) return;
    (void)hipMemsetAsync((char*)d_ws + WS_CTL, 0, CTL_ZERO_BYTES, stream);
    Args a{};
    for (int i = 0; i < 37; ++i) a.in[i] = d_in[i];
    a.out = (float*)d_out; a.ws = (unsigned char*)d_ws;
#if DEBUG_HYBRID
    unsigned char* ws = (unsigned char*)d_ws; bf16_t* WT = (bf16_t*)(ws + WS_WT);
    bf16_t* XN = (bf16_t*)(ws + WS_A); bf16_t* Y = XN; bf16_t* OX = XN; bf16_t* Z = (bf16_t*)(ws + WS_Z); bf16_t* X1B = Z;
    bf16_t* QX = (bf16_t*)(ws + WS_QX); bf16_t* Q = (bf16_t*)(ws + WS_Q); bf16_t* KV = (bf16_t*)(ws + WS_KV); bf16_t* KPE = (bf16_t*)(ws + WS_KPE); bf16_t* YG = (bf16_t*)(ws + WS_YG);
    bf16_t* YMOE = (bf16_t*)(ws + WS_YMOE); bf16_t* MEMN = (bf16_t*)(ws + WS_MEMN); bf16_t* KX = (bf16_t*)(ws + WS_KX); bf16_t* VXT = (bf16_t*)(ws + WS_VXT);
    const f32x2* ROPE = (const f32x2*)(ws + WS_ROPE); float* SC = (float*)(ws + WS_SC); unsigned* ctlw = (unsigned*)(ws + WS_CTL);
    ss_t* SSQ = (ss_t*)(ctlw + CW_SSQ); ss_t* SSKV = (ss_t*)(ctlw + CW_SSKV); ss_t* SSMLA = (ss_t*)(ctlw + CW_SSMLA); ss_t* SSSSM = (ss_t*)(ctlw + CW_SSSSM); ss_t* SSX1 = (ss_t*)(ctlw + CW_SSX1);
    const float* const* fin = (const float* const*)d_in; float* out = (float*)d_out;
    for (int s = 0; s < NPHASE; ++s) {
        if (s == 0 || ((FASTMASK >> s) & 1)) { a.ph_lo = s; a.ph_hi = s + 1; hipLaunchKernelGGL(mega_fwd, dim3(grid), dim3(NWAVES * 64), LDS_BYTES, stream, a); continue; }
        switch (s) {
        case 1: hipLaunchKernelGGL(nv::gemm<nv::EZ>, dim3(25, 256), dim3(256), 0, stream, XN, 1024, WT + WT_IN, 1024, 1024, nv::EZ{Z, SSQ, SSKV, KPE, ROPE});
                hipLaunchKernelGGL(nv::gemm<nv::EStore>, dim3(16, 16), dim3(256), 0, stream, MEMN, 1024, WT + WT_XK, 1024, 1024, nv::EStore{KX, 1024});
                hipLaunchKernelGGL(nv::gemm<nv::EVXT>, dim3(16, 16), dim3(256), 0, stream, WT + WT_XV, 1024, MEMN, 1024, 1024, nv::EVXT{VXT}); break;
        case 2: hipLaunchKernelGGL(nv::ssm_a, dim3(2048), dim3(64), 0, stream, Z, ws + WS_TAB, SC);
                hipLaunchKernelGGL(nv::gemm<nv::EQ>, dim3(12, 256), dim3(256), 0, stream, Z + 512, ZP, WT + WT_QUP, 768, 768, nv::EQ{Q, SSQ, ROPE});
                hipLaunchKernelGGL(nv::gemm<nv::EKV>, dim3(16, 256), dim3(256), 0, stream, Z + 1280, ZP, WT + WT_KVUP, 256, 256, nv::EKV{KV, SSKV}); break;
        case 3: hipLaunchKernelGGL(nv::ssm_c, dim3(128), dim3(64), 0, stream, Z, ws + WS_TAB, fin[I_SD], YG);
                hipLaunchKernelGGL(nv::mla_attn, dim3(4 * 8 * 64), dim3(64), 0, stream, Q, KV, KPE, Y, SSMLA); break;
        case 4: hipLaunchKernelGGL(nv::gemm<nv::EGLU>, dim3(8, 256), dim3(256), 0, stream, YG, 512, WT + WT_GLU, 512, 512, nv::EGLU{YG, fin[I_BGLU], Y, SSSSM}); break;
        case 5: hipLaunchKernelGGL(nv::gemm<nv::EOutA>, dim3(16, 256), dim3(256), 0, stream, Y, 1024, WT + WT_OUT, 1024, 512, nv::EOutA{fin[I_X], out, SSSSM});
                hipLaunchKernelGGL(nv::gemm<nv::EOutB>, dim3(16, 256), dim3(256), 0, stream, Y + 512, 1024, WT + WT_OUT + 512, 1024, 512, nv::EOutB{out, X1B, SSMLA, SSX1}); break;
        case 6: hipLaunchKernelGGL(nv::gemm<nv::EXQ>, dim3(16, 256), dim3(256), 0, stream, X1B, 1024, WT + WT_XQ, 1024, 1024, nv::EXQ{QX, SSX1});
                hipLaunchKernelGGL(nv::xattn, dim3(T * 4), dim3(256), 0, stream, QX, KX, VXT, OX); break;
        case 7: hipLaunchKernelGGL(nv::gemm<nv::EAdd>, dim3(16, 256), dim3(256), 0, stream, OX, 1024, WT + WT_XO, 1024, 1024, nv::EAdd{out}); break;
        case 8: hipLaunchKernelGGL(nv::router, dim3(T), dim3(256), 0, stream, out, fin[I_GMOE], fin[I_WGRP], fin[I_BGRP], fin[I_WEXP], fin[I_BEXP], ws); break;
        case 9: hipLaunchKernelGGL(nv::moe_slot, dim3(T * 2), dim3(256), 0, stream, ws); break;
        case 10: break;
        case 11: hipLaunchKernelGGL(nv::final_rows, dim3(T), dim3(256), 0, stream, out, YMOE, fin[I_GFIN]); break;
        }
    }
#else
    a.ph_lo = 0; a.ph_hi = NPHASE;
    hipLaunchKernelGGL(mega_fwd, dim3(grid), dim3(NWAVES * 64), LDS_BYTES, stream, a);
#endif
    const hipError_t le = hipPeekAtLastError();
    if (le != hipSuccess) fprintf(stderr, "kernel_launch: launch failed: %s\n", hipGetErrorName(le));
}
```

```cpp
#define DEBUG_HYBRID 0
#define FASTMASK 0xFFF

#include <hip/hip_runtime.h>
#include <cstdio>
#include <cstdint>

#define LAS __attribute__((address_space(3)))
#define GAS __attribute__((address_space(1)))
typedef unsigned short bf16_t;
typedef short bf16x8 __attribute__((ext_vector_type(8)));
typedef short s16x4 __attribute__((ext_vector_type(4)));
typedef float f32x2 __attribute__((ext_vector_type(2)));
typedef float f32x4 __attribute__((ext_vector_type(4)));
typedef float f32x8 __attribute__((ext_vector_type(8)));
typedef float f32x16 __attribute__((ext_vector_type(16)));
typedef unsigned u32x2 __attribute__((ext_vector_type(2)));
typedef unsigned u32x4 __attribute__((ext_vector_type(4)));

constexpr int T = 16384, DM = 1024, SEQ = 4096, NBATCH = 4, DIN = 1568, ZP = 1792, NMEM = 256;
constexpr int NEXP = 32, LCAP = 16384;
constexpr float EPS = 1e-6f;
constexpr float LOG2E = 1.4426950408889634f;
constexpr float QS = 0.10206207261596577f * LOG2E;
constexpr float XS = 0.0625f * LOG2E;

constexpr size_t MiB = 1u << 20;
constexpr size_t WS_CTL = 0, CTL_ZERO_BYTES = 1 * MiB;
constexpr size_t WS_ROPE = 1 * MiB;
constexpr size_t WS_MEMN = 3 * MiB;
constexpr size_t WS_KX = 5 * MiB;
constexpr size_t WS_VXT = 7 * MiB;
constexpr size_t WS_SC = 9 * MiB;
constexpr size_t WS_TAB = 10 * MiB;
constexpr size_t TAB_ABAR = 0, TAB_A256 = 16384, TAB_BBT = 65536, TAB_CCT = 262144, TAB_WRH = 524288, TAB_WRL = 524288 + 131072;
constexpr size_t WS_LIST = 11 * MiB;
constexpr size_t WS_LISTD = 13 * MiB;
constexpr size_t WS_LISTW = 15 * MiB;
constexpr size_t WS_TOKI = 17 * MiB;
constexpr size_t WS_WT = 18 * MiB;
constexpr size_t WS_A = 82 * MiB;
constexpr size_t WS_Z = 114 * MiB;
constexpr size_t WS_QX = 146 * MiB;
constexpr size_t WS_Q = 170 * MiB;
constexpr size_t WS_PB = 178 * MiB;
constexpr size_t WS_KV = 194 * MiB;
constexpr size_t WS_KPE = 226 * MiB;
constexpr size_t WS_YG = 227 * MiB;
constexpr size_t WS_YMOE = 166 * MiB;
constexpr size_t WS_END = 256 * MiB;
constexpr size_t WT_IN = 0, WT_QUP = WT_IN + (size_t)ZP * 1024, WT_KVUP = WT_QUP + 768 * 768, WT_GLU = WT_KVUP + 1024 * 256, WT_OUT = WT_GLU + 512 * 512,
                 WT_XQ = WT_OUT + 1024 * 1024, WT_XK = WT_XQ + 1024 * 1024, WT_XV = WT_XK + 1024 * 1024, WT_XO = WT_XV + 1024 * 1024,
                 WT_GU = WT_XO + 1024 * 1024, WT_D = WT_GU + (size_t)32 * 512 * 1024, WT_END = WT_D + (size_t)32 * 1024 * 256;
static_assert(WT_END * 2 <= 64 * MiB, "weights fit");
constexpr int CW_TMO = 0, CW_BAR = 4096  , CW_CNT = 15360, CW_SSQ = 16384, CW_SSKV = CW_SSQ + 2 * T, CW_SSMLA = CW_SSKV + 2 * T, CW_SSSSM = CW_SSMLA + 2 * T, CW_SSX1 = CW_SSSSM + 2 * T;
static_assert((CW_SSX1 + 2 * T) * 4 <= (int)CTL_ZERO_BYTES, "ctl");
typedef unsigned long long ss_t;

__device__ __forceinline__ unsigned f2bf(float f) { unsigned u = __builtin_bit_cast(unsigned, f); return (u + 0x7fffu + ((u >> 16) & 1u)) >> 16; }
__device__ __forceinline__ float bf2f(unsigned short b) { return __builtin_bit_cast(float, (unsigned)b << 16); }
__device__ __forceinline__ unsigned pk2(float lo, float hi) { return f2bf(lo) | (f2bf(hi) << 16); }
__device__ __forceinline__ float bflo(unsigned w) { return __builtin_bit_cast(float, w << 16); }
__device__ __forceinline__ float bfhi(unsigned w) { return __builtin_bit_cast(float, w & 0xffff0000u); }
__device__ __forceinline__ float wave_sum(float v) {
#pragma unroll
    for (int o = 1; o < 64; o <<= 1) v += __shfl_xor(v, o);
    return v;
}
__device__ __forceinline__ float gelu_tanh(float v) {
    const float z = 0.7978845608028654f * (v + 0.044715f * v * v * v);
    const float e = __expf(2.f * z);
    const float th = 1.f - 2.f / (1.f + e);
    return 0.5f * v * (1.f + th);
}
__device__ __forceinline__ void ss_add(ss_t* p, float s) { atomicAdd(p, (ss_t)(s * 16777216.f)); }
__device__ __forceinline__ float ss_get(const ss_t* p) { return (float)(*p) * (1.f / 16777216.f); }
__device__ __forceinline__ float sigmoidf_(float v) { return 1.f / (1.f + __expf(-v)); }

namespace pg8 {
constexpr int BM = 256, BK = 64, HALF = 128, HTB = HALF * BK * 2, STAGE_BYTES = 8 * HTB, NXCD = 8, WGM = 8;
__host__ __device__ __forceinline__ int lds_byte(int r, int c) { const int st = (r >> 4) * 2 + (c >> 5), rr = r & 15, cc = c & 31, ob = rr * 64 + cc * 2; return st * 1024 + (ob ^ (((ob >> 9) & 1) << 5)); }
__host__ __device__ __forceinline__ void stage_rc(int b, int& R, int& C) { const int st = b / 1024, sb = b % 1024, swz = sb ^ (((sb >> 9) & 1) << 5); R = (st >> 1) * 16 + swz / 64; C = (st & 1) * 32 + (swz % 64) / 2; }
__host__ __device__ __forceinline__ int perm32(int rho) { const int n = rho >> 4, i = rho & 15; return 8 * (i >> 2) + 4 * n + (i & 3); }

struct Unit { int pm, pn, aux; };

struct GridOrder {
    int nM, nN, nwg, G, c;
    __device__ __forceinline__ void init(int nM_, int nN_, int G_, int c_) { nM = nM_; nN = nN_; nwg = nM * nN; G = G_; c = c_; }
    __device__ __forceinline__ bool get(int i, int& pm, int& pn) const {
        if (c < 0 || c >= G) return false;
        const long L = (long)i * G + c; if (L >= nwg) return false;
        int wgid = (int)L; { const int q = nwg / NXCD, r = nwg % NXCD, xcd = wgid % NXCD, off = wgid / NXCD; wgid = (xcd < r ? xcd * (q + 1) : r * (q + 1) + (xcd - r) * q) + off; }
        const int nig = WGM * nN, gid = wgid / nig, fm = gid * WGM, gsz = (nM - fm) < WGM ? (nM - fm) : WGM;
        pm = fm + ((wgid % nig) % gsz); pn = (wgid % nig) / gsz; return true;
    }
};

#define PG8_LAS LAS
template <class Epi, class Prob, bool ALIGN_EPI>
__device__ __forceinline__ void gemm_phase(PG8_LAS unsigned char* lds, const Prob& S, const Epi& E) {
    const int tid = threadIdx.x, wid = __builtin_amdgcn_readfirstlane(tid >> 6), lane = tid & 63, wr = wid >> 2, wc = wid & 3, fr = lane & 15, fq = lane >> 4;
    int R[2], C[2]; unsigned vB[2][2];
#pragma unroll
    for (int i = 0; i < 2; ++i) { stage_rc(tid * 16 + i * 8192, R[i], C[i]); const int Rb = Epi::PERM ? ((R[i] & ~31) + perm32(R[i] & 31)) : R[i];
        vB[0][i] = (unsigned)(Rb * S.ldb + C[i]) * 2u; vB[1][i] = (unsigned)((Rb + HALF) * S.ldb + C[i]) * 2u; }
    const size_t kstep = (size_t)(BK * 2);
    const unsigned ldsw = (unsigned)wid * 1024u;
    const int aoff = lds_byte(wr * 64 + fr, fq * 8), boff = lds_byte(wc * 32 + fr, fq * 8);
#define PG8_SA(b, h) (((b) * 2 + (h)) * HTB)
#define PG8_SB(b, h) ((4 + (b) * 2 + (h)) * HTB)
#define PG8_STAGE(bufoff, gbase, voff) do { _Pragma("unroll") for (int _i = 0; _i < 2; ++_i) \
        __builtin_amdgcn_global_load_lds((const unsigned*)((const char*)(gbase) + (voff)[_i]), (PG8_LAS unsigned*)(lds + (bufoff) + ldsw + _i * 8192), 16, 0, 0); } while (0)
#define PG8_LDA(dst, b, h) do { _Pragma("unroll") for (int m = 0; m < 4; ++m) _Pragma("unroll") for (int k = 0; k < 2; ++k) dst[m][k] = *(const PG8_LAS bf16x8*)(lds + PG8_SA(b, h) + aoff + m * 2048 + k * 1024); } while (0)
#define PG8_LDB(dst, b, h) do { _Pragma("unroll") for (int n = 0; n < 2; ++n) _Pragma("unroll") for (int k = 0; k < 2; ++k) dst[n][k] = *(const PG8_LAS bf16x8*)(lds + PG8_SB(b, h) + boff + n * 2048 + k * 1024); } while (0)
#define PG8_MMA(ai, bj, At, Bt) do { __builtin_amdgcn_s_setprio(1); _Pragma("unroll") for (int m = 0; m < 4; ++m) _Pragma("unroll") for (int n = 0; n < 2; ++n) _Pragma("unroll") for (int k = 0; k < 2; ++k) \
        acc[ai][bj][m][n] = __builtin_amdgcn_mfma_f32_16x16x32_bf16(Bt[n][k], At[m][k], acc[ai][bj][m][n], 0, 0, 0); __builtin_amdgcn_s_setprio(0); } while (0)
#define PG8_WAIT_V(n) asm volatile("s_waitcnt vmcnt(" #n ")" ::: "memory")
#define PG8_WAIT_L(n) asm volatile("s_waitcnt lgkmcnt(" #n ")" ::: "memory")
#define PG8_BAR __builtin_amdgcn_s_barrier()
#define PG8_SCHED __builtin_amdgcn_sched_barrier(0)
    Unit cur, nxt; int ui = 0;
    if (!S.next(0, cur)) return;
    unsigned vA[2][2], vAn[2][2];
    S.a_off(cur, R, C, vA);
    f32x4 acc[2][2][4][2];
#pragma unroll
    for (int a = 0; a < 2; ++a)
#pragma unroll
        for (int b = 0; b < 2; ++b)
#pragma unroll
            for (int m = 0; m < 4; ++m)
#pragma unroll
                for (int n = 0; n < 2; ++n) acc[a][b][m][n] = (f32x4){0.f, 0.f, 0.f, 0.f};
    bf16x8 At[4][2], B0[2][2], B1[2][2];
    const char* cA = S.a_ptr(cur); const char* cB = S.b_ptr(cur);
    int nt = S.nkt(cur);
    PG8_STAGE(PG8_SB(0, 0), cB, vB[0]); PG8_STAGE(PG8_SB(0, 1), cB, vB[1]); PG8_STAGE(PG8_SA(0, 0), cA, vA[0]); PG8_STAGE(PG8_SA(0, 1), cA, vA[1]);
    if (wr == 1) PG8_BAR;
    PG8_WAIT_V(2); PG8_BAR;
    PG8_STAGE(PG8_SB(1, 0), cB + kstep, vB[0]); PG8_STAGE(PG8_SA(1, 0), cA + kstep, vA[0]); PG8_STAGE(PG8_SB(1, 1), cB + kstep, vB[1]);
    PG8_WAIT_V(6); PG8_BAR;
    for (;;) {
        const bool has_next = S.next(ui + 1, nxt);
        const char* nA = has_next ? S.a_ptr(nxt) : cA; const char* nB = has_next ? S.b_ptr(nxt) : cB;
        if constexpr (Prob::GATHER) { if (has_next) S.a_off(nxt, R, C, vAn); else { vAn[0][0] = vA[0][0]; vAn[0][1] = vA[0][1]; vAn[1][0] = vA[1][0]; vAn[1][1] = vA[1][1]; } }
        for (int t = 0; t < nt; t += 2) {
            const bool last = (t == nt - 2);
            if constexpr (Epi::MIDK) { if (t == (nt >> 1)) { int fr3 = fr, fq3 = fq; asm volatile("" : "+v"(fr3), "+v"(fq3)); E.mid(acc, cur, wr, wc, fr3, fq3); } }
            const char* a1 = cA + (size_t)(t + 1) * kstep;
            const char* a2 = last ? nA : cA + (size_t)(t + 2) * kstep; const char* b2 = last ? nB : cB + (size_t)(t + 2) * kstep;
            const char* a3 = a2 + kstep; const char* b3 = b2 + kstep;
            unsigned w0[2], w1[2];
            if constexpr (Prob::GATHER) { w0[0] = last ? vAn[0][0] : vA[0][0]; w0[1] = last ? vAn[0][1] : vA[0][1]; w1[0] = last ? vAn[1][0] : vA[1][0]; w1[1] = last ? vAn[1][1] : vA[1][1]; }
            else { w0[0] = vA[0][0]; w0[1] = vA[0][1]; w1[0] = vA[1][0]; w1[1] = vA[1][1]; }
            PG8_LDB(B0, 0, 0); PG8_LDB(B1, 0, 1); PG8_SCHED; PG8_LDA(At, 0, 0); PG8_STAGE(PG8_SA(1, 1), a1, vA[1]);
            PG8_WAIT_V(8); PG8_WAIT_L(0); PG8_BAR; PG8_MMA(0, 0, At, B0); PG8_MMA(0, 1, At, B1); PG8_BAR; PG8_SCHED;
            PG8_LDA(At, 0, 1); PG8_STAGE(PG8_SB(0, 0), b2, vB[0]); PG8_STAGE(PG8_SB(0, 1), b2, vB[1]); PG8_STAGE(PG8_SA(0, 0), a2, w0);
            PG8_WAIT_V(8); PG8_WAIT_L(0); PG8_BAR; PG8_MMA(1, 0, At, B0); PG8_MMA(1, 1, At, B1); PG8_BAR; PG8_SCHED;
            PG8_LDB(B0, 1, 0); PG8_LDB(B1, 1, 1); PG8_SCHED; PG8_LDA(At, 1, 0); PG8_STAGE(PG8_SA(0, 1), a2, w1);
            PG8_WAIT_V(8); PG8_WAIT_L(0); PG8_BAR; PG8_MMA(0, 0, At, B0); PG8_MMA(0, 1, At, B1); PG8_BAR; PG8_SCHED;
            PG8_LDA(At, 1, 1); PG8_STAGE(PG8_SB(1, 0), b3, vB[0]); PG8_STAGE(PG8_SB(1, 1), b3, vB[1]); PG8_STAGE(PG8_SA(1, 0), a3, w0);
            PG8_WAIT_V(8); PG8_WAIT_L(0); PG8_BAR; PG8_MMA(1, 0, At, B0); PG8_MMA(1, 1, At, B1); PG8_BAR; PG8_SCHED;
        }
        if constexpr (ALIGN_EPI) { if (wr == 0) PG8_BAR; }
        if constexpr (!Epi::AFTER_DRAIN) { int fr2 = fr, fq2 = fq; asm volatile("" : "+v"(fr2), "+v"(fq2)); E(acc, cur, wr, wc, fr2, fq2); }
        if (!has_next) break;
#pragma unroll
        for (int a = 0; a < 2; ++a)
#pragma unroll
            for (int b = 0; b < 2; ++b)
#pragma unroll
                for (int m = 0; m < 4; ++m)
#pragma unroll
                    for (int n = 0; n < 2; ++n) acc[a][b][m][n] = (f32x4){0.f, 0.f, 0.f, 0.f};
        cur = nxt; cA = nA; cB = nB; ++ui; nt = S.nkt(cur);
        if constexpr (Prob::GATHER) { vA[0][0] = vAn[0][0]; vA[0][1] = vAn[0][1]; vA[1][0] = vAn[1][0]; vA[1][1] = vAn[1][1]; }
        if constexpr (ALIGN_EPI) { if (wr == 1) PG8_BAR; }
    }
    PG8_WAIT_V(0);
    if constexpr (!ALIGN_EPI) { if (wr == 0) PG8_BAR; }
    PG8_BAR;
    if constexpr (Epi::AFTER_DRAIN) { int fr2 = fr, fq2 = fq; asm volatile("" : "+v"(fr2), "+v"(fq2)); E.fused(acc, cur, wr, wc, fr2, fq2, lds, wid, lane); }
#undef PG8_SA
#undef PG8_SB
#undef PG8_STAGE
#undef PG8_LDA
#undef PG8_LDB
#undef PG8_MMA
#undef PG8_WAIT_V
#undef PG8_WAIT_L
#undef PG8_BAR
#undef PG8_SCHED
}

struct ProbDense {
    static constexpr bool GATHER = false;
    const bf16_t* A; const bf16_t* Bt; int lda, ldb, K; GridOrder O;
    __device__ __forceinline__ bool next(int i, Unit& u) const { u.aux = 0; return O.get(i, u.pm, u.pn); }
    __device__ __forceinline__ int nkt(const Unit&) const { return K / BK; }
    __device__ __forceinline__ const char* a_ptr(const Unit& u) const { return (const char*)(A + (size_t)u.pm * BM * lda); }
    __device__ __forceinline__ const char* b_ptr(const Unit& u) const { return (const char*)(Bt + (size_t)u.pn * BM * ldb); }
    __device__ __forceinline__ void a_off(const Unit&, const int (&R)[2], const int (&C)[2], unsigned (&v)[2][2]) const {
#pragma unroll
        for (int i = 0; i < 2; ++i) { v[0][i] = (unsigned)(R[i] * lda + C[i]) * 2u; v[1][i] = (unsigned)((R[i] + HALF) * lda + C[i]) * 2u; }
    }
};
struct ProbOne {
    static constexpr bool GATHER = false;
    const bf16_t* A; const bf16_t* Bt; int lda, ldb, K, pm, pn;
    __device__ __forceinline__ bool next(int i, Unit& u) const { u.pm = pm; u.pn = pn; u.aux = 0; return i == 0; }
    __device__ __forceinline__ int nkt(const Unit&) const { return K / BK; }
    __device__ __forceinline__ const char* a_ptr(const Unit&) const { return (const char*)A; }
    __device__ __forceinline__ const char* b_ptr(const Unit&) const { return (const char*)Bt; }
    __device__ __forceinline__ void a_off(const Unit&, const int (&R)[2], const int (&C)[2], unsigned (&v)[2][2]) const {
#pragma unroll
        for (int i = 0; i < 2; ++i) { v[0][i] = (unsigned)(R[i] * lda + C[i]) * 2u; v[1][i] = (unsigned)((R[i] + HALF) * lda + C[i]) * 2u; }
    }
};
}

namespace epi {
using pg8::Unit;
typedef f32x4 Acc[2][2][4][2];
__device__ __forceinline__ u32x4 pack8(const f32x4 a, const f32x4 b) { u32x4 w; w.x = pk2(a[0], a[1]); w.y = pk2(a[2], a[3]); w.z = pk2(b[0], b[1]); w.w = pk2(b[2], b[3]); return w; }
__device__ __forceinline__ float sq4(const f32x4 a) { return (a[0] * a[0] + a[1] * a[1]) + (a[2] * a[2] + a[3] * a[3]); }
__device__ __forceinline__ void rope8(f32x4& v0, f32x4& v1, const f32x2* rp  , int fq) {
    float o[8], v[8] = {v0[0], v0[1], v0[2], v0[3], v1[0], v1[1], v1[2], v1[3]};
#pragma unroll
    for (int j = 0; j < 8; ++j) o[j] = __shfl_xor(v[j], 32);
    const int i0 = 8 * (fq & 1);
#pragma unroll
    for (int j = 0; j < 8; ++j) { const f32x2 cs = rp[i0 + j]; v[j] = (fq < 2) ? (v[j] * cs.x - o[j] * cs.y) : (o[j] * cs.y + v[j] * cs.x); }
    v0 = (f32x4){v[0], v[1], v[2], v[3]}; v1 = (f32x4){v[4], v[5], v[6], v[7]};
}

struct EpiZ {
    static constexpr bool PERM = true, AFTER_DRAIN = false, MIDK = false;
    bf16_t* z; ss_t* ssq; ss_t* sskv; bf16_t* kpe; const f32x2* rope;
    __device__ __forceinline__ void operator()(const Acc& acc, const Unit& u, int wr, int wc, int fr, int fq) const {
        const int pn = u.pn;
        if (pn < 6) {
#pragma unroll
            for (int ai = 0; ai < 2; ++ai)
#pragma unroll
                for (int m = 0; m < 4; ++m) { const int row = u.pm * 256 + ai * 128 + wr * 64 + m * 16 + fr; float s = 0.f;
#pragma unroll
                    for (int bj = 0; bj < 2; ++bj) { const int col = pn * 256 + bj * 128 + wc * 32 + 8 * fq;
                        *(u32x4*)(z + (size_t)row * ZP + col) = pack8(acc[ai][bj][m][0], acc[ai][bj][m][1]); s += sq4(acc[ai][bj][m][0]) + sq4(acc[ai][bj][m][1]); }
                    if (pn >= 2) { s += __shfl_xor(s, 16); s += __shfl_xor(s, 32); if (fq == 0) ss_add((pn < 5 ? ssq : sskv) + row, s); } }
        } else if (wc == 0) {
#pragma unroll
            for (int ai = 0; ai < 2; ++ai)
#pragma unroll
                for (int m = 0; m < 4; ++m) { const int row = u.pm * 256 + ai * 128 + wr * 64 + m * 16 + fr;
                    f32x4 v0 = acc[ai][0][m][0], v1 = acc[ai][0][m][1]; rope8(v0, v1, rope + (size_t)row * 16, fq);
                    *(u32x4*)(kpe + (size_t)row * 32 + 8 * fq) = pack8(v0, v1); }
        }
    }
};
struct EpiStore {
    static constexpr bool PERM = true, AFTER_DRAIN = false, MIDK = false;
    bf16_t* O; int ldc;
    __device__ __forceinline__ void operator()(const Acc& acc, const Unit& u, int wr, int wc, int fr, int fq) const {
#pragma unroll
        for (int ai = 0; ai < 2; ++ai)
#pragma unroll
            for (int m = 0; m < 4; ++m) { const int row = u.pm * 256 + ai * 128 + wr * 64 + m * 16 + fr;
#pragma unroll
                for (int bj = 0; bj < 2; ++bj) { const int col = u.pn * 256 + bj * 128 + wc * 32 + 8 * fq;
                    *(u32x4*)(O + (size_t)row * ldc + col) = pack8(acc[ai][bj][m][0], acc[ai][bj][m][1]); } }
    }
};
struct EpiVXT {
    static constexpr bool PERM = true, AFTER_DRAIN = false, MIDK = false;
    bf16_t* O;
    __device__ __forceinline__ void operator()(const Acc& acc, const Unit& u, int wr, int wc, int fr, int fq) const {
#pragma unroll
        for (int ai = 0; ai < 2; ++ai)
#pragma unroll
            for (int m = 0; m < 4; ++m) { const int row = u.pm * 256 + ai * 128 + wr * 64 + m * 16 + fr;
#pragma unroll
                for (int bj = 0; bj < 2; ++bj) { const int key = bj * 128 + wc * 32 + 8 * fq;
                    *(u32x4*)(O + (size_t)u.pn * 262144 + (size_t)row * 256 + key) = pack8(acc[ai][bj][m][0], acc[ai][bj][m][1]); } }
    }
};
struct EpiQ {
    static constexpr bool PERM = true, AFTER_DRAIN = false, MIDK = false;
    bf16_t* q; const ss_t* ssq; const f32x2* rope;
    __device__ __forceinline__ void operator()(const Acc& acc, const Unit& u, int wr, int wc, int fr, int fq) const {
#pragma unroll
        for (int ai = 0; ai < 2; ++ai)
#pragma unroll
            for (int m = 0; m < 4; ++m) { const int row = u.pm * 256 + ai * 128 + wr * 64 + m * 16 + fr;
                const float rs = __builtin_amdgcn_rsqf(ss_get(ssq + row) * (1.f / 768.f) + EPS) * QS;
#pragma unroll
                for (int bj = 0; bj < 2; ++bj) { const int g32 = u.pn * 8 + bj * 4 + wc, col = g32 * 32 + 8 * fq;
                    f32x4 v0 = acc[ai][bj][m][0] * rs, v1 = acc[ai][bj][m][1] * rs;
                    if (g32 % 3 == 2) rope8(v0, v1, rope + (size_t)row * 16, fq);
                    *(u32x4*)(q + (size_t)row * 768 + col) = pack8(v0, v1); } }
    }
};
struct EpiKV {
    static constexpr bool PERM = true, AFTER_DRAIN = false, MIDK = false;
    bf16_t* kv; const ss_t* sskv;
    __device__ __forceinline__ void operator()(const Acc& acc, const Unit& u, int wr, int wc, int fr, int fq) const {
#pragma unroll
        for (int ai = 0; ai < 2; ++ai)
#pragma unroll
            for (int m = 0; m < 4; ++m) { const int row = u.pm * 256 + ai * 128 + wr * 64 + m * 16 + fr;
                const float rs = __builtin_amdgcn_rsqf(ss_get(sskv + row) * (1.f / 256.f) + EPS);
#pragma unroll
                for (int bj = 0; bj < 2; ++bj) { const int col = u.pn * 256 + bj * 128 + wc * 32 + 8 * fq;
                    *(u32x4*)(kv + (size_t)row * 1024 + col) = pack8(acc[ai][bj][m][0] * rs, acc[ai][bj][m][1] * rs); } }
    }
};
struct EpiGLU {
    static constexpr bool PERM = true, AFTER_DRAIN = false, MIDK = false;
    const bf16_t* yg; const float* bias; bf16_t* y; ss_t* ss;
    __device__ __forceinline__ void operator()(const Acc& acc, const Unit& u, int wr, int wc, int fr, int fq) const {
#pragma unroll
        for (int ai = 0; ai < 2; ++ai)
#pragma unroll
            for (int m = 0; m < 4; ++m) { const int row = u.pm * 256 + ai * 128 + wr * 64 + m * 16 + fr; float s = 0.f;
#pragma unroll
                for (int bj = 0; bj < 2; ++bj) { const int col = u.pn * 256 + bj * 128 + wc * 32 + 8 * fq;
                    const u32x4 g = *(const u32x4*)(yg + (size_t)row * 512 + col);
                    const f32x4 b0 = *(const f32x4*)(bias + col), b1 = *(const f32x4*)(bias + col + 4);
                    const f32x4 a0 = acc[ai][bj][m][0] + b0, a1 = acc[ai][bj][m][1] + b1;
                    f32x4 o0, o1;
                    o0[0] = bflo(g.x) * sigmoidf_(a0[0]); o0[1] = bfhi(g.x) * sigmoidf_(a0[1]); o0[2] = bflo(g.y) * sigmoidf_(a0[2]); o0[3] = bfhi(g.y) * sigmoidf_(a0[3]);
                    o1[0] = bflo(g.z) * sigmoidf_(a1[0]); o1[1] = bfhi(g.z) * sigmoidf_(a1[1]); o1[2] = bflo(g.w) * sigmoidf_(a1[2]); o1[3] = bfhi(g.w) * sigmoidf_(a1[3]);
                    s += sq4(o0) + sq4(o1);
                    *(u32x4*)(y + (size_t)row * 1024 + col) = pack8(o0, o1); }
                s += __shfl_xor(s, 16); s += __shfl_xor(s, 32); if (fq == 0) ss_add(ss + row, s); }
    }
};
struct EpiOutA {
    static constexpr bool PERM = false, AFTER_DRAIN = false, MIDK = false;
    const float* base; float* out; const ss_t* ss;
    __device__ __forceinline__ void operator()(const Acc& acc, const Unit& u, int wr, int wc, int fr, int fq) const {
#pragma unroll
        for (int ai = 0; ai < 2; ++ai)
#pragma unroll
            for (int m = 0; m < 4; ++m) { const int row = u.pm * 256 + ai * 128 + wr * 64 + m * 16 + fr;
                const float rs = __builtin_amdgcn_rsqf(ss_get(ss + row) * (1.f / 512.f) + EPS);
#pragma unroll
                for (int bj = 0; bj < 2; ++bj)
#pragma unroll
                    for (int n = 0; n < 2; ++n) { const size_t off = (size_t)row * 1024 + u.pn * 256 + bj * 128 + wc * 32 + 16 * n + 4 * fq;
                        *(f32x4*)(out + off) = *(const f32x4*)(base + off) + acc[ai][bj][m][n] * rs; } }
    }
};
struct EpiOutB {
    static constexpr bool PERM = false, AFTER_DRAIN = false, MIDK = false;
    float* out; bf16_t* xb; const ss_t* ss; ss_t* ssx;
    __device__ __forceinline__ void operator()(const Acc& acc, const Unit& u, int wr, int wc, int fr, int fq) const {
#pragma unroll
        for (int ai = 0; ai < 2; ++ai)
#pragma unroll
            for (int m = 0; m < 4; ++m) { const int row = u.pm * 256 + ai * 128 + wr * 64 + m * 16 + fr; float s = 0.f;
                const float rs = __builtin_amdgcn_rsqf(ss_get(ss + row) * (1.f / 512.f) + EPS);
#pragma unroll
                for (int bj = 0; bj < 2; ++bj)
#pragma unroll
                    for (int n = 0; n < 2; ++n) { const size_t off = (size_t)row * 1024 + u.pn * 256 + bj * 128 + wc * 32 + 16 * n + 4 * fq;
                        const f32x4 x1 = *(const f32x4*)(out + off) + acc[ai][bj][m][n] * rs; s += sq4(x1);
                        *(f32x4*)(out + off) = x1; u32x2 w; w.x = pk2(x1[0], x1[1]); w.y = pk2(x1[2], x1[3]); *(u32x2*)(xb + off) = w; }
                s += __shfl_xor(s, 16); s += __shfl_xor(s, 32); if (fq == 0) ss_add(ssx + row, s); }
    }
};
struct EpiOut {
    static constexpr bool PERM = false, AFTER_DRAIN = false, MIDK = true;
    const float* base; float* out; bf16_t* xb; const ss_t* ss1; const ss_t* ss2; ss_t* ssx;
    __device__ __forceinline__ void mid(Acc& acc, const Unit& u, int wr, int wc, int fr, int fq) const {
#pragma unroll
        for (int ai = 0; ai < 2; ++ai)
#pragma unroll
            for (int m = 0; m < 4; ++m) { const int row = u.pm * 256 + ai * 128 + wr * 64 + m * 16 + fr;
                const float r1 = __builtin_amdgcn_rsqf(ss_get(ss1 + row) * (1.f / 512.f) + EPS), r2 = __builtin_amdgcn_rsqf(ss_get(ss2 + row) * (1.f / 512.f) + EPS); const float f = r1 / r2;
#pragma unroll
                for (int bj = 0; bj < 2; ++bj)
#pragma unroll
                    for (int n = 0; n < 2; ++n) acc[ai][bj][m][n] = acc[ai][bj][m][n] * f;
                asm volatile("" ::: "memory"); }
    }
    __device__ __forceinline__ void operator()(const Acc& acc, const Unit& u, int wr, int wc, int fr, int fq) const {
#pragma unroll
        for (int ai = 0; ai < 2; ++ai)
#pragma unroll
            for (int m = 0; m < 4; ++m) { const int row = u.pm * 256 + ai * 128 + wr * 64 + m * 16 + fr; float s = 0.f;
                const float rs = __builtin_amdgcn_rsqf(ss_get(ss2 + row) * (1.f / 512.f) + EPS);
#pragma unroll
                for (int bj = 0; bj < 2; ++bj)
#pragma unroll
                    for (int n = 0; n < 2; ++n) { const size_t off = (size_t)row * 1024 + u.pn * 256 + bj * 128 + wc * 32 + 16 * n + 4 * fq;
                        const f32x4 x1 = *(const f32x4*)(base + off) + acc[ai][bj][m][n] * rs; s += sq4(x1);
                        *(f32x4*)(out + off) = x1; u32x2 w; w.x = pk2(x1[0], x1[1]); w.y = pk2(x1[2], x1[3]); *(u32x2*)(xb + off) = w; }
                s += __shfl_xor(s, 16); s += __shfl_xor(s, 32); if (fq == 0) ss_add(ssx + row, s); }
    }
};
struct EpiXQ {
    static constexpr bool PERM = true, AFTER_DRAIN = false, MIDK = false;
    bf16_t* O; const ss_t* ss;
    __device__ __forceinline__ void operator()(const Acc& acc, const Unit& u, int wr, int wc, int fr, int fq) const {
#pragma unroll
        for (int ai = 0; ai < 2; ++ai)
#pragma unroll
            for (int m = 0; m < 4; ++m) { const int row = u.pm * 256 + ai * 128 + wr * 64 + m * 16 + fr;
                const float rs = __builtin_amdgcn_rsqf(ss_get(ss + row) * (1.f / 1024.f) + EPS) * XS;
#pragma unroll
                for (int bj = 0; bj < 2; ++bj) { const int col = u.pn * 256 + bj * 128 + wc * 32 + 8 * fq;
                    *(u32x4*)(O + (size_t)row * 1024 + col) = pack8(acc[ai][bj][m][0] * rs, acc[ai][bj][m][1] * rs); } }
    }
};
struct EpiSoft {
    static constexpr bool PERM = true, AFTER_DRAIN = true, MIDK = false;
    bf16_t* P; float* lrow;
    __device__ __forceinline__ void fused(Acc& acc, const Unit& u, int wr, int wc, int fr, int fq, LAS unsigned char* lds, int wid, int lane) const {
        LAS float* M1 = (LAS float*)lds;
        LAS float* M2 = (LAS float*)(lds + 4096);
#pragma unroll
        for (int ai = 0; ai < 2; ++ai)
#pragma unroll
            for (int m = 0; m < 4; ++m) { float mx = -3.0e38f;
#pragma unroll
                for (int bj = 0; bj < 2; ++bj)
#pragma unroll
                    for (int n = 0; n < 2; ++n) { const f32x4 x = acc[ai][bj][m][n]; mx = fmaxf(mx, fmaxf(fmaxf(x[0], x[1]), fmaxf(x[2], x[3]))); }
                mx = fmaxf(mx, __shfl_xor(mx, 16)); mx = fmaxf(mx, __shfl_xor(mx, 32));
                if (fq == 0) M1[(ai * 128 + wr * 64 + m * 16 + fr) * 4 + wc] = mx; }
        asm volatile("s_waitcnt lgkmcnt(0)" ::: "memory"); __builtin_amdgcn_s_barrier(); asm volatile("" ::: "memory");
#pragma unroll
        for (int ai = 0; ai < 2; ++ai)
#pragma unroll
            for (int m = 0; m < 4; ++m) { const int r = ai * 128 + wr * 64 + m * 16 + fr; const int row = u.pm * 256 + r;
                const f32x4 mm = *(const LAS f32x4*)(M1 + r * 4); const float mx = fmaxf(fmaxf(mm[0], mm[1]), fmaxf(mm[2], mm[3])); float s = 0.f;
#pragma unroll
                for (int bj = 0; bj < 2; ++bj) { f32x4 p0, p1;
#pragma unroll
                    for (int e = 0; e < 4; ++e) { p0[e] = __builtin_amdgcn_exp2f(acc[ai][bj][m][0][e] - mx); p1[e] = __builtin_amdgcn_exp2f(acc[ai][bj][m][1][e] - mx); }
                    s += (p0[0] + p0[1]) + (p0[2] + p0[3]) + (p1[0] + p1[1]) + (p1[2] + p1[3]);
                    const int col = u.pn * 256 + bj * 128 + wc * 32 + 8 * fq;
                    *(u32x4*)(P + (size_t)row * 1024 + col) = pack8(p0, p1); }
                s += __shfl_xor(s, 16); s += __shfl_xor(s, 32);
                if (fq == 0) M2[r * 4 + wc] = s; }
        asm volatile("s_waitcnt lgkmcnt(0)" ::: "memory"); __builtin_amdgcn_s_barrier(); asm volatile("" ::: "memory");
        if (wid < 4) { const int r = wid * 64 + lane; const f32x4 ss = *(const LAS f32x4*)(M2 + r * 4);
            __hip_atomic_store(lrow + (size_t)(u.pm * 256 + r) * 4 + u.pn, (ss[0] + ss[1]) + (ss[2] + ss[3]), __ATOMIC_RELAXED, __HIP_MEMORY_SCOPE_AGENT); }
    }
};
struct EpiPV {
    static constexpr bool PERM = true, AFTER_DRAIN = false, MIDK = false;
    bf16_t* O; const float* lrow;
    __device__ __forceinline__ void operator()(const Acc& acc, const Unit& u, int wr, int wc, int fr, int fq) const {
#pragma unroll
        for (int ai = 0; ai < 2; ++ai)
#pragma unroll
            for (int m = 0; m < 4; ++m) { const int row = u.pm * 256 + ai * 128 + wr * 64 + m * 16 + fr;
                const float rl = 1.f / __hip_atomic_load(lrow + (size_t)row * 4 + u.pn, __ATOMIC_RELAXED, __HIP_MEMORY_SCOPE_AGENT);
#pragma unroll
                for (int bj = 0; bj < 2; ++bj) { const int col = u.pn * 256 + bj * 128 + wc * 32 + 8 * fq;
                    *(u32x4*)(O + (size_t)row * 1024 + col) = pack8(acc[ai][bj][m][0] * rl, acc[ai][bj][m][1] * rl); } }
    }
};
struct EpiAdd {
    static constexpr bool PERM = false, AFTER_DRAIN = false, MIDK = false;
    const float* in; float* out;
    __device__ __forceinline__ void operator()(const Acc& acc, const Unit& u, int wr, int wc, int fr, int fq) const {
#pragma unroll
        for (int ai = 0; ai < 2; ++ai)
#pragma unroll
            for (int m = 0; m < 4; ++m) { const int row = u.pm * 256 + ai * 128 + wr * 64 + m * 16 + fr;
#pragma unroll
                for (int bj = 0; bj < 2; ++bj)
#pragma unroll
                    for (int n = 0; n < 2; ++n) { const size_t off = (size_t)row * 1024 + u.pn * 256 + bj * 128 + wc * 32 + 16 * n + 4 * fq;
                        *(f32x4*)(out + off) = *(const f32x4*)(in + off) + acc[ai][bj][m][n]; } }
    }
};
}

namespace mla {
constexpr int NW = 8, QBLK = 32, KVBLK = 64;
constexpr int SHM_V = KVBLK * 64 * 2, SHM_K = KVBLK * 256;
constexpr int LDS_V = 0, LDS_K = 2 * SHM_V, LDS_WS = LDS_K + 2 * SHM_K, LDS_BYTES = LDS_WS + NW * 64 * 4;
constexpr float THR = 8.f;
#define KSWZ(row, colB) ((row) * 256 + ((colB) ^ (((row) & 7) << 4)))
#define SBAR() __builtin_amdgcn_sched_barrier(0)
__device__ __forceinline__ int crow(int r, int hi) { return (r & 3) + 8 * (r >> 2) + 4 * hi; }
__device__ __forceinline__ unsigned cvtpk(float lo, float hi) { unsigned r; asm volatile("v_cvt_pk_bf16_f32 %0, %1, %2" : "=v"(r) : "v"(lo), "v"(hi)); return r; }
__device__ __forceinline__ void partialSM(f32x16& p0, f32x16& p1, float& m_reg, float& mn, float& alpha) {
    float pmax = p0[0];
#pragma unroll
    for (int r = 1; r < 16; ++r) pmax = fmaxf(pmax, p0[r]);
#pragma unroll
    for (int r = 0; r < 16; ++r) pmax = fmaxf(pmax, p1[r]);
    { auto rr = __builtin_amdgcn_permlane32_swap(__float_as_uint(pmax), __float_as_uint(pmax), false, false); pmax = fmaxf(__uint_as_float(rr[0]), __uint_as_float(rr[1])); }
    if (__builtin_expect(__all(pmax - m_reg <= THR), 1)) { mn = m_reg; alpha = 1.f; }
    else { mn = fmaxf(m_reg, pmax); alpha = __builtin_amdgcn_exp2f(m_reg - mn); m_reg = mn; }
#pragma unroll
    for (int r = 0; r < 16; ++r) p0[r] = p0[r] - mn;
#pragma unroll
    for (int r = 0; r < 16; ++r) p1[r] = p1[r] - mn;
#pragma unroll
    for (int r = 0; r < 16; ++r) p0[r] = __builtin_amdgcn_exp2f(p0[r]);
}
__device__ __forceinline__ void finishSM(f32x16& p0, f32x16& p1, float alpha, float& l_reg, bf16x8& pa0, bf16x8& pa1, bf16x8& pa2, bf16x8& pa3) {
#pragma unroll
    for (int r = 0; r < 16; ++r) p1[r] = __builtin_amdgcn_exp2f(p1[r]);
    float ps = 0;
#pragma unroll
    for (int r = 0; r < 16; ++r) ps += p0[r];
#pragma unroll
    for (int r = 0; r < 16; ++r) ps += p1[r];
    { auto rr = __builtin_amdgcn_permlane32_swap(__float_as_uint(ps), __float_as_uint(ps), false, false); ps = __uint_as_float(rr[0]) + __uint_as_float(rr[1]); }
    l_reg = l_reg * alpha + ps;
#define PK4(P, BASE, OUT) do { unsigned a0 = cvtpk(P[BASE + 0], P[BASE + 1]), a1 = cvtpk(P[BASE + 2], P[BASE + 3]);   \
    unsigned b0 = cvtpk(P[BASE + 4], P[BASE + 5]), b1 = cvtpk(P[BASE + 6], P[BASE + 7]);                              \
    auto r0 = __builtin_amdgcn_permlane32_swap(a0, b0, false, false); auto r1 = __builtin_amdgcn_permlane32_swap(a1, b1, false, false); \
    u32x4 w = {r0[0], r1[0], r0[1], r1[1]}; OUT = *reinterpret_cast<bf16x8*>(&w); } while (0)
    PK4(p0, 0, pa0); PK4(p0, 8, pa1); PK4(p1, 0, pa2); PK4(p1, 8, pa3);
#undef PK4
}
__device__ __forceinline__ void qkt(f32x16& p0, f32x16& p1, const char* Ks, const bf16x8* qr, int r32, int hi, bool masked) {
    p0 = f32x16{}; p1 = f32x16{};
#pragma unroll
    for (int d0 = 0; d0 < 6; ++d0) { const int cb = (d0 * 16 + hi * 8) * 2;
        const bf16x8 b0 = *reinterpret_cast<const bf16x8*>(Ks + KSWZ(r32, cb));
        const bf16x8 b1 = *reinterpret_cast<const bf16x8*>(Ks + KSWZ(32 + r32, cb));
        p0 = __builtin_amdgcn_mfma_f32_32x32x16_bf16(b0, qr[d0], p0, 0, 0, 0);
        p1 = __builtin_amdgcn_mfma_f32_32x32x16_bf16(b1, qr[d0], p1, 0, 0, 0); }
    if (masked) {
#pragma unroll
        for (int r = 0; r < 16; ++r) { p0[r] = -INFINITY; p1[r] = -INFINITY; } }
}
__device__ __forceinline__ int v_st(int k, int c) { const int kk = (k & ~0xC) | ((k & 4) << 1) | ((k & 8) >> 1); return ((kk >> 3) * 2 + (c >> 5)) * 512 + ((kk & 7) * 32 + (c & 31)) * 2; }
__device__ __forceinline__ int v_rd_base(int lane) { return ((lane & 3) << 3) | (((lane >> 2) & 3) << 6) | (((lane >> 4) & 1) << 5) | (((lane >> 5) & 1) << 8); }
constexpr int v_rd_off(int d0, int ks, int half) { return d0 * 512 + ks * 2048 + half * 1024; }
template <int OFF> __device__ __forceinline__ s16x4 tr_read(int vb) { s16x4 r; asm volatile("ds_read_b64_tr_b16 %0, %1 offset:%2" : "=&v"(r) : "v"(vb), "i"(OFF) : "memory"); return r; }
template <int D0> __device__ __forceinline__ void pv_one(f32x16& od, int vb, bf16x8 pa0, bf16x8 pa1, bf16x8 pa2, bf16x8 pa3) {
    const s16x4 l0 = tr_read<v_rd_off(D0, 0, 0)>(vb), h0 = tr_read<v_rd_off(D0, 0, 1)>(vb), l1 = tr_read<v_rd_off(D0, 1, 0)>(vb), h1 = tr_read<v_rd_off(D0, 1, 1)>(vb);
    const s16x4 l2 = tr_read<v_rd_off(D0, 2, 0)>(vb), h2 = tr_read<v_rd_off(D0, 2, 1)>(vb), l3 = tr_read<v_rd_off(D0, 3, 0)>(vb), h3 = tr_read<v_rd_off(D0, 3, 1)>(vb);
    asm volatile("s_waitcnt lgkmcnt(0)" ::: "memory"); SBAR();
#define PK(L, H) (bf16x8){L[0], L[1], L[2], L[3], H[0], H[1], H[2], H[3]}
    od = __builtin_amdgcn_mfma_f32_32x32x16_bf16(pa0, PK(l0, h0), od, 0, 0, 0);
    od = __builtin_amdgcn_mfma_f32_32x32x16_bf16(pa1, PK(l1, h1), od, 0, 0, 0);
    od = __builtin_amdgcn_mfma_f32_32x32x16_bf16(pa2, PK(l2, h2), od, 0, 0, 0);
    od = __builtin_amdgcn_mfma_f32_32x32x16_bf16(pa3, PK(l3, h3), od, 0, 0, 0);
#undef PK
}
__device__ __forceinline__ void pv_d0(f32x16* o, int vb, bf16x8 pa0, bf16x8 pa1, bf16x8 pa2, bf16x8 pa3) { pv_one<0>(o[0], vb, pa0, pa1, pa2, pa3); pv_one<1>(o[1], vb, pa0, pa1, pa2, pa3); }

__device__ __forceinline__ void unit(int b, int h, int qb, const bf16_t* __restrict__ q, const bf16_t* __restrict__ kv, const bf16_t* __restrict__ kpe, bf16_t* y, ss_t* ssm, char* lds) {
    const int tid = threadIdx.x, wid = tid >> 6, lane = tid & 63, r32 = lane & 31, hi = lane >> 5;
    char* V_lds = lds + LDS_V; char* K_lds = lds + LDS_K;
    float* ws = (float*)(lds + LDS_WS) + wid * 64; float* li_l = ws; float* al_l = ws + 32;
    float m_reg = -1e30f, l_reg = 0; f32x16 o[2] = {}; bf16x8 qr[6];
    const size_t row0 = (size_t)b * SEQ + (size_t)qb * 256, krow0 = (size_t)b * SEQ;
    const bf16_t* Qw = q + (row0 + wid * QBLK + r32) * 768 + h * 96 + hi * 8;
#pragma unroll
    for (int d0 = 0; d0 < 6; ++d0) qr[d0] = *reinterpret_cast<const bf16x8*>(Qw + d0 * 16);
    const int skey = tid >> 3, sc = (tid & 7) * 8, pkey = (tid & 255) >> 2, pc = (tid & 3) * 8;
    const int vst = v_st(skey, sc), kst = KSWZ(skey, sc * 2), pst = KSWZ(pkey, (64 + pc) * 2);
    const int vb0 = (int)(uintptr_t)V_lds + v_rd_base(lane);
    const char* kvb = (const char*)(kv + krow0 * 1024 + h * 128);
    const char* kpb = (const char*)(kpe + krow0 * 32);
    const unsigned koff = (unsigned)(skey * 1024 + sc) * 2u, poff = (unsigned)(pkey * 32 + pc) * 2u;
    struct { bf16x8 v, k, p; } sr_[2];
#define SLOAD(i, k0) do { const char* kb_ = kvb + (size_t)(k0) * 2048; sr_[i].v = *reinterpret_cast<const bf16x8*>(kb_ + 128 + koff); sr_[i].k = *reinterpret_cast<const bf16x8*>(kb_ + koff); \
    sr_[i].p = *reinterpret_cast<const bf16x8*>(kpb + (size_t)(k0) * 64 + poff); } while (0)
#define SWRITE(bb, i) do { *(bf16x8*)(V_lds + (bb) * SHM_V + vst) = sr_[i].v; *(bf16x8*)(K_lds + (bb) * SHM_K + kst) = sr_[i].k; \
    if (tid < 256) *(bf16x8*)(K_lds + (bb) * SHM_K + pst) = sr_[i].p; } while (0)
#define SWAIT() asm volatile("s_waitcnt vmcnt(3)" ::: "memory")
#define RESC(a) do { if (__any((a) < 1.f)) { if (hi == 0) al_l[r32] = (a); asm volatile("s_waitcnt lgkmcnt(0)" ::: "memory"); \
    _Pragma("unroll") for (int d = 0; d < 2; ++d) _Pragma("unroll") for (int r = 0; r < 16; ++r) o[d][r] *= al_l[crow(r, hi)]; } } while (0)
    f32x16 pA0, pA1, pB0, pB1; float mnA, mnB, alA, alB; bf16x8 pa0, pa1, pa2, pa3;
    const int NT = 4 * qb + 4, tmax = 4 * qb + (wid >> 1);
    constexpr int SE = 0, SO = 1;
    SLOAD(SE, 0); asm volatile("s_waitcnt vmcnt(0)" ::: "memory"); SWRITE(0, SE); __syncthreads();
    qkt(pA0, pA1, K_lds, qr, r32, hi, false); partialSM(pA0, pA1, m_reg, mnA, alA);
    SLOAD(SO, KVBLK); if (2 < NT) SLOAD(SE, 2 * KVBLK);
    SWAIT(); SWRITE(1, SO); __syncthreads();
    for (int j = 1; j + 1 < NT; j += 2) {
        SBAR(); qkt(pB0, pB1, K_lds + SHM_K, qr, r32, hi, j > tmax);
        finishSM(pA0, pA1, alA, l_reg, pa0, pa1, pa2, pa3); SBAR();
        SLOAD(SO, (j + 2) * KVBLK); SBAR();
        pv_d0(o, vb0, pa0, pa1, pa2, pa3); partialSM(pB0, pB1, m_reg, mnB, alB);
        __syncthreads(); SWAIT(); SWRITE(0, SE);
        RESC(alB); __syncthreads();
        SBAR(); qkt(pA0, pA1, K_lds, qr, r32, hi, (j + 1) > tmax);
        finishSM(pB0, pB1, alB, l_reg, pa0, pa1, pa2, pa3); SBAR();
        if (j + 3 < NT) SLOAD(SE, (j + 3) * KVBLK); SBAR();
        pv_d0(o, vb0 + SHM_V, pa0, pa1, pa2, pa3); partialSM(pA0, pA1, m_reg, mnA, alA);
        __syncthreads(); SWAIT(); SWRITE(1, SO);
        RESC(alA); __syncthreads();
    }
    SBAR(); qkt(pB0, pB1, K_lds + SHM_K, qr, r32, hi, (NT - 1) > tmax);
    finishSM(pA0, pA1, alA, l_reg, pa0, pa1, pa2, pa3); SBAR();
    pv_d0(o, vb0, pa0, pa1, pa2, pa3); partialSM(pB0, pB1, m_reg, mnB, alB);
    __syncthreads(); RESC(alB);
    finishSM(pB0, pB1, alB, l_reg, pa0, pa1, pa2, pa3); SBAR();
    pv_d0(o, vb0 + SHM_V, pa0, pa1, pa2, pa3);
    if (hi == 0) li_l[r32] = l_reg; asm volatile("s_waitcnt lgkmcnt(0)" ::: "memory");
    float rli[16];
#pragma unroll
    for (int r = 0; r < 16; ++r) rli[r] = __builtin_amdgcn_rcpf(li_l[crow(r, hi)]);
    bf16_t* Ow = y + (row0 + wid * QBLK) * 1024 + 512 + h * 64;
#pragma unroll
    for (int r = 0; r < 16; ++r) { const int orow = crow(r, hi); const float a = o[0][r] * rli[r], c = o[1][r] * rli[r];
        Ow[(size_t)orow * 1024 + r32] = (bf16_t)f2bf(a); Ow[(size_t)orow * 1024 + 32 + r32] = (bf16_t)f2bf(c);
        float s = a * a + c * c;
        s += __shfl_xor(s, 1); s += __shfl_xor(s, 2); s += __shfl_xor(s, 4); s += __shfl_xor(s, 8); s += __shfl_xor(s, 16);
        if (r32 == 0) ss_add(ssm + row0 + wid * QBLK + orow, s); }
    __syncthreads();
#undef SLOAD
#undef SWRITE
#undef SWAIT
#undef RESC
}
#undef KSWZ
#undef SBAR
}

namespace ssm {
__device__ __forceinline__ int crow(int r, int hi) { return (r & 3) + 8 * (r >> 2) + 4 * hi; }
template <bool FINAL>
__device__ __forceinline__ void item(int it, const bf16_t* z, const f32x2* abar, const f32x2* a256, const bf16_t* BBT, const bf16_t* CCT, const float* dskip,
                                     float* Sc, bf16_t* yg, LAS bf16_t* xl, int lane) {
    const int c = it & 15, g = (it >> 4) & 31, b = it >> 9, r32 = lane & 31, hi = lane >> 5;
    const size_t t0 = (size_t)b * SEQ + (size_t)c * 256;
    bf16x8 bb[4];
#pragma unroll
    for (int nb = 0; nb < 4; ++nb) bb[nb] = *(const bf16x8*)(BBT + ((size_t)(g * 128 + nb * 32 + r32) * 16 + hi * 8));
    const f32x2 a0 = abar[g * 64 + r32], a1 = abar[g * 64 + 32 + r32];
    float xr0 = 0.f, xi0 = 0.f, xr1 = 0.f, xi1 = 0.f;
    bf16x8 cc[8]; float dsk[16];
    if constexpr (FINAL) {
        const f32x2 A0 = a256[g * 64 + r32], A1 = a256[g * 64 + 32 + r32];
        for (int k = 0; k < c; ++k) { const float* S = Sc + (size_t)((b * 32 + g) * 16 + k) * 128;
            const float s0r = S[r32], s0i = S[32 + r32], s1r = S[64 + r32], s1i = S[96 + r32];
            const float n0r = A0.x * xr0 - A0.y * xi0 + s0r, n0i = A0.x * xi0 + A0.y * xr0 + s0i, n1r = A1.x * xr1 - A1.y * xi1 + s1r, n1i = A1.x * xi1 + A1.y * xr1 + s1i;
            xr0 = n0r; xi0 = n0i; xr1 = n1r; xi1 = n1i; }
#pragma unroll
        for (int s = 0; s < 8; ++s) cc[s] = *(const bf16x8*)(CCT + ((size_t)(g * 32 + r32) * 128 + s * 16 + hi * 8));
#pragma unroll
        for (int j = 0; j < 16; ++j) dsk[j] = dskip[g * 16 + j];
    }
#pragma unroll 1
    for (int blk = 0; blk < 8; ++blk) {
        const bf16x8 u8 = *(const bf16x8*)(z + (t0 + blk * 32 + r32) * ZP + g * 16 + hi * 8);
        f32x16 X[4];
#pragma unroll
        for (int nb = 0; nb < 4; ++nb) X[nb] = __builtin_amdgcn_mfma_f32_32x32x16_bf16(u8, bb[nb], f32x16{}, 0, 0, 0);
#pragma unroll
        for (int grp = 0; grp < 8; ++grp) { const int owner = grp & 1, rb = 4 * (grp >> 1);
            if (hi == owner) {
#pragma unroll
                for (int i = 0; i < 4; ++i) { const int r = rb + i;
                    const float n0r = a0.x * xr0 - a0.y * xi0 + X[0][r], n0i = a0.x * xi0 + a0.y * xr0 + X[1][r];
                    const float n1r = a1.x * xr1 - a1.y * xi1 + X[2][r], n1i = a1.x * xi1 + a1.y * xr1 + X[3][r];
                    xr0 = n0r; xi0 = n0i; xr1 = n1r; xi1 = n1i; X[0][r] = n0r; X[1][r] = n0i; X[2][r] = n1r; X[3][r] = n1i; } }
            const float t0r = __shfl_xor(xr0, 32), t0i = __shfl_xor(xi0, 32), t1r = __shfl_xor(xr1, 32), t1i = __shfl_xor(xi1, 32);
            if (hi != owner) { xr0 = t0r; xi0 = t0i; xr1 = t1r; xi1 = t1i; } }
        if constexpr (FINAL) {
#pragma unroll
            for (int nb = 0; nb < 4; ++nb)
#pragma unroll
                for (int r = 0; r < 16; ++r) xl[crow(r, hi) * 136 + nb * 32 + r32] = (bf16_t)f2bf(X[nb][r]);
            asm volatile("s_waitcnt lgkmcnt(0)" ::: "memory");
            f32x16 yv = f32x16{};
#pragma unroll
            for (int s = 0; s < 8; ++s) { const bf16x8 xa = *(const LAS bf16x8*)(xl + r32 * 136 + s * 16 + hi * 8); yv = __builtin_amdgcn_mfma_f32_32x32x16_bf16(xa, cc[s], yv, 0, 0, 0); }
            asm volatile("s_waitcnt lgkmcnt(0)" ::: "memory");
            LAS float* yl = (LAS float*)(xl + 32 * 136);
            if (r32 < 16) {
#pragma unroll
                for (int r = 0; r < 16; ++r) yl[crow(r, hi) * 17 + r32] = yv[r]; }
            asm volatile("s_waitcnt lgkmcnt(0)" ::: "memory");
            { const int tl = lane >> 1, hh = lane & 1; const size_t tok = t0 + blk * 32 + tl;
              const u32x4 uw = *(const u32x4*)(z + tok * ZP + g * 16 + hh * 8);
              const float uu[8] = {bflo(uw.x), bfhi(uw.x), bflo(uw.y), bfhi(uw.y), bflo(uw.z), bfhi(uw.z), bflo(uw.w), bfhi(uw.w)};
              float ov[8];
#pragma unroll
              for (int j = 0; j < 8; ++j) ov[j] = gelu_tanh(yl[tl * 17 + hh * 8 + j] + dsk[hh * 8 + j] * uu[j]);
              u32x4 ow; ow.x = pk2(ov[0], ov[1]); ow.y = pk2(ov[2], ov[3]); ow.z = pk2(ov[4], ov[5]); ow.w = pk2(ov[6], ov[7]);
              *(u32x4*)(yg + tok * 512 + g * 16 + hh * 8) = ow; }
            asm volatile("s_waitcnt lgkmcnt(0)" ::: "memory");
        }
    }
    if constexpr (!FINAL) { if (hi == 0) { float* S = Sc + (size_t)it * 128; S[r32] = xr0; S[32 + r32] = xi0; S[64 + r32] = xr1; S[96 + r32] = xi1; } }
}
}

namespace moe {
using pg8::Unit;
struct Ctx { const LAS int* tmap; int ntile; const unsigned* cnt; const int* list; const int* listd; const float* listw; const float* rstd3; };
struct ProbGU {
    static constexpr bool GATHER = true;
    const bf16_t* A; const bf16_t* Bt; int ldb; Ctx X; int G, c;
    __device__ __forceinline__ bool next(int i, Unit& u) const { const int L = i * G + c; if (L >= X.ntile * 2) return false; u.pm = L >> 1; u.pn = L & 1; u.aux = X.tmap[u.pm]; return true; }
    __device__ __forceinline__ int nkt(const Unit&) const { return 16; }
    __device__ __forceinline__ const char* a_ptr(const Unit&) const { return (const char*)A; }
    __device__ __forceinline__ const char* b_ptr(const Unit& u) const { return (const char*)(Bt + ((size_t)(u.aux & 255) * 512 + u.pn * 256) * 1024); }
    __device__ __forceinline__ void a_off(const Unit& u, const int (&R)[2], const int (&C)[2], unsigned (&v)[2][2]) const {
        const int e = u.aux & 255, rt = u.aux >> 8; const int n = (int)X.cnt[e];
#pragma unroll
        for (int h = 0; h < 2; ++h)
#pragma unroll
            for (int i = 0; i < 2; ++i) { const int pos = rt * 256 + h * 128 + R[i]; const int tok = pos < n ? X.list[e * LCAP + pos] : 0; v[h][i] = (unsigned)(tok * 1024 + C[i]) * 2u; }
    }
};
struct EpiGU {
    static constexpr bool PERM = true, AFTER_DRAIN = false, MIDK = false;
    bf16_t* h1; Ctx X;
    __device__ __forceinline__ void operator()(const epi::Acc& acc, const Unit& u, int wr, int wc, int fr, int fq) const {
        const int e = u.aux & 255, rt = u.aux >> 8; const int n = (int)X.cnt[e];
#pragma unroll
        for (int ai = 0; ai < 2; ++ai)
#pragma unroll
            for (int m = 0; m < 4; ++m) { const int r = ai * 128 + wr * 64 + m * 16 + fr, pos = rt * 256 + r; const size_t srow = (size_t)u.pm * 256 + r;
                const int tok = pos < n ? X.list[e * LCAP + pos] : 0; const float rs = X.rstd3[tok];
                f32x4 o0, o1;
#pragma unroll
                for (int k = 0; k < 4; ++k) { const float g0 = acc[ai][0][m][0][k] * rs, u0 = acc[ai][1][m][0][k] * rs, g1 = acc[ai][0][m][1][k] * rs, u1 = acc[ai][1][m][1][k] * rs;
                    o0[k] = g0 * sigmoidf_(g0) * u0; o1[k] = g1 * sigmoidf_(g1) * u1; }
                *(u32x4*)(h1 + srow * 256 + u.pn * 128 + wc * 32 + 8 * fq) = epi::pack8(o0, o1); asm volatile("" ::: "memory"); }
    }
};
struct ProbD {
    static constexpr bool GATHER = false;
    const bf16_t* A; const bf16_t* Bt; int ldb; Ctx X; int G, c, nk;
    __device__ __forceinline__ bool next(int i, Unit& u) const { const int L = i * G + c; if (L >= X.ntile * 4) return false; u.pm = L >> 2; u.pn = L & 3; u.aux = X.tmap[u.pm]; return true; }
    __device__ __forceinline__ int nkt(const Unit&) const { return nk; }
    __device__ __forceinline__ const char* a_ptr(const Unit& u) const { return (const char*)(A + (size_t)u.pm * 256 * 256); }
    __device__ __forceinline__ const char* b_ptr(const Unit& u) const { return (const char*)(Bt + ((size_t)(u.aux & 255) * 1024 + u.pn * 256) * 256); }
    __device__ __forceinline__ void a_off(const Unit&, const int (&R)[2], const int (&C)[2], unsigned (&v)[2][2]) const {
#pragma unroll
        for (int i = 0; i < 2; ++i) { v[0][i] = (unsigned)(R[i] * 256 + C[i]) * 2u; v[1][i] = (unsigned)((R[i] + 128) * 256 + C[i]) * 2u; }
    }
};
struct EpiD {
    static constexpr bool PERM = true, AFTER_DRAIN = false, MIDK = false;
    bf16_t* ymoe; Ctx X;
    __device__ __forceinline__ void operator()(const epi::Acc& acc, const Unit& u, int wr, int wc, int fr, int fq) const {
        const int e = u.aux & 255, rt = u.aux >> 8; const int n = (int)X.cnt[e];
#pragma unroll
        for (int ai = 0; ai < 2; ++ai)
#pragma unroll
            for (int m = 0; m < 4; ++m) { const int r = ai * 128 + wr * 64 + m * 16 + fr, pos = rt * 256 + r;
                const bool ok = pos < n; const int li = ok ? e * LCAP + pos : 0; const int dst = ok ? X.listd[li] : 2 * T; const float w = ok ? X.listw[li] : 0.f;
#pragma unroll
                for (int bj = 0; bj < 2; ++bj) { const int col = u.pn * 256 + bj * 128 + wc * 32 + 8 * fq;
                    *(u32x4*)(ymoe + (size_t)dst * 1024 + col) = epi::pack8(acc[ai][bj][m][0] * w, acc[ai][bj][m][1] * w); }
                asm volatile("" ::: "memory"); }
    }
};
}

typedef GAS unsigned gu32;
#define RLX_AGENT __ATOMIC_RELAXED, __HIP_MEMORY_SCOPE_AGENT
#define XB_TMO      128
#define XB_XCNT(j)  (256  + 64 * (j))
#define XB_XSUB(j)  (1280 + 64 * (j))
#define XB_XGEN(j)  (2304 + 64 * (j))
#define XB_TOP      3328
#define XB_TOPGEN   3392
#define XCD_BAR_WORDS 3456
#define XB_SPIN_CAP (1u << 18)
__device__ __forceinline__ unsigned xb_ld(unsigned* p)              { return __hip_atomic_load(p, __ATOMIC_RELAXED, __HIP_MEMORY_SCOPE_AGENT); }
__device__ __forceinline__ unsigned xb_add(unsigned* p, unsigned v) { return __hip_atomic_fetch_add(p, v, __ATOMIC_RELAXED, __HIP_MEMORY_SCOPE_AGENT); }
__device__ __forceinline__ unsigned xb_xcc_id() { return (unsigned)__builtin_amdgcn_s_getreg((3 << 11) | 20) & 0xFu; }
#define XB_SPIN(cond, bar) do { unsigned _sp = 0; while (cond) { __builtin_amdgcn_s_sleep(1); \
    if ((++_sp & 255u) == 0u) { if (xb_ld(&(bar)[XB_TMO])) break; if (_sp > XB_SPIN_CAP) { atomicAdd(&(bar)[XB_TMO], 1u); break; } } } } while (0)
struct XcdBarrier { unsigned* bar; unsigned x; volatile LAS unsigned* st; };
__device__ __forceinline__ XcdBarrier xcd_barrier_post(unsigned* bar, volatile LAS unsigned* st) {
    XcdBarrier b; b.bar = bar; b.x = xb_xcc_id(); b.st = st;
    if (threadIdx.x == 0) (void)xb_add(&bar[XB_XCNT(b.x)], 1u);
    return b;
}
__device__ __forceinline__ void xcd_barrier_complete(unsigned* bar, unsigned x, unsigned& nloc, unsigned& nx) {
    const unsigned G = gridDim.x * gridDim.y * gridDim.z;
    unsigned sum, cnt, mine, sp = 0u;
    for (;;) {
        sum = 0u; cnt = 0u; mine = 0u;
#pragma unroll
        for (unsigned j = 0; j < 16; ++j) { const unsigned c = xb_ld(&bar[XB_XCNT(j)]); sum += c; cnt += (c > 0u) ? 1u : 0u; mine = (j == x) ? c : mine; }
        if (sum == G) break;
        __builtin_amdgcn_s_sleep(1);
        if ((++sp & 255u) == 0u) { if (xb_ld(&bar[XB_TMO])) break; if (sp > XB_SPIN_CAP) { atomicAdd(&bar[XB_TMO], 1u); break; } }
    }
    nloc = mine > 0u ? mine : 1u; nx = cnt > 0u ? cnt : 1u;
}
__device__ __forceinline__ void xcd_barrier(const XcdBarrier& b) {
    asm volatile("s_waitcnt vmcnt(0)" ::: "memory");
    __syncthreads();
    if (threadIdx.x == 0) {
        unsigned* bar = b.bar;
        __builtin_amdgcn_s_waitcnt(0);
        unsigned nloc = b.st[0], nx = b.st[1];
        if (nloc == 0u) { xcd_barrier_complete(bar, b.x, nloc, nx); b.st[0] = nloc; b.st[1] = nx; }
        const unsigned old = xb_add(&bar[XB_XSUB(b.x)], 1u);
        const unsigned gen = old / nloc;
        if (old + 1u == (gen + 1u) * nloc) {
            __builtin_amdgcn_fence(__ATOMIC_RELEASE, "agent");
            asm volatile("s_waitcnt vmcnt(0)" ::: "memory");
            const unsigned og = xb_add(&bar[XB_TOP], 1u);
            const unsigned tg = og / nx;
            if (og + 1u == (tg + 1u) * nx) xb_add(&bar[XB_TOPGEN], 1u);
            else XB_SPIN(xb_ld(&bar[XB_TOPGEN]) == tg, bar);
            __builtin_amdgcn_fence(__ATOMIC_ACQUIRE, "agent");
            xb_add(&bar[XB_XGEN(b.x)], 1u);
            asm volatile("s_waitcnt vmcnt(0)" ::: "memory");
        } else {
            XB_SPIN(xb_ld(&bar[XB_XGEN(b.x)]) == gen, bar);
            __builtin_amdgcn_fence(__ATOMIC_ACQUIRE, "agent");
            asm volatile("s_waitcnt vmcnt(0)" ::: "memory");
        }
    }
    __syncthreads();
}
__device__ __forceinline__ void cu_sync_global() {
    asm volatile("s_waitcnt vmcnt(0)" ::: "memory");
    __syncthreads();
    if (threadIdx.x == 0) { __builtin_amdgcn_fence(__ATOMIC_ACQUIRE, "agent"); asm volatile("s_waitcnt vmcnt(0)" ::: "memory"); }
    __syncthreads();
}

constexpr int NWAVES = 8;
constexpr int RING_BYTES = 131072, LDSCTL_OFF = RING_BYTES, MISC_OFF = LDSCTL_OFF + 320, TMAP_OFF = LDSCTL_OFF + 1024, LDS_BYTES = 147456;
struct Args { const void* in[37]; float* out; unsigned char* ws; int ph_lo, ph_hi, dry, li; };
enum { I_X = 0, I_MEM, I_POS, I_GMIX, I_WIN, I_LRE, I_LIM, I_LDT, I_BRE, I_BIM, I_CRE, I_CIM, I_SD, I_WGLU, I_BGLU, I_GQ, I_WQUP, I_GKV, I_WKVUP, I_GSSM, I_GMLA, I_WOUT,
       I_GX, I_GMEM, I_XWQ, I_XWK, I_XWV, I_XWO, I_GMOE, I_WGRP, I_BGRP, I_WEXP, I_BEXP, I_WGATE, I_WUP, I_WDOWN, I_GFIN };

struct Frame {
    LAS unsigned char* lds; unsigned char* ws; float* out; const void* const* in;
    int tid, lane, wave, vcu, G;
    __device__ __forceinline__ const float* f(int i) const { return (const float*)in[i]; }
    __device__ __forceinline__ bf16_t* wt(size_t off) const { return (bf16_t*)(ws + WS_WT) + off; }
    __device__ __forceinline__ ss_t* ctlf(int w) const { return (ss_t*)((unsigned*)(ws + WS_CTL) + w); }
};

__device__ __forceinline__ void tr_item(const float* W, int N, bf16_t* WT, int ldk, int k0, int n0, int drow0, const float* g0, const float* g1, LAS float* scr, int lane) {
#pragma unroll 8
    for (int i = 0; i < 32; ++i) { const int kk = 2 * i + (lane >> 5), k = k0 + kk; float gn = 1.f; if (g0) gn = (g1 && k >= 512) ? g1[k - 512] : g0[k];
        scr[kk * 33 + (lane & 31)] = W[(size_t)k * N + n0 + (lane & 31)] * gn; }
    asm volatile("s_waitcnt lgkmcnt(0)" ::: "memory");
    const int c = lane & 7;
#pragma unroll
    for (int j = 0; j < 4; ++j) { const int n = (lane >> 3) + 8 * j; const LAS float* s = scr + (8 * c) * 33 + n;
        u32x4 o; o.x = pk2(s[0 * 33], s[1 * 33]); o.y = pk2(s[2 * 33], s[3 * 33]); o.z = pk2(s[4 * 33], s[5 * 33]); o.w = pk2(s[6 * 33], s[7 * 33]);
        *(u32x4*)(WT + (size_t)(drow0 + n) * ldk + k0 + 8 * c) = o; }
    asm volatile("s_waitcnt lgkmcnt(0)" ::: "memory");
}
__device__ __forceinline__ void rms_row_to_bf16(const float* xrow, const float* gain, bf16_t* orow, int lane) {
    const f32x4* xr = (const f32x4*)xrow + lane; const f32x4* gr = (const f32x4*)gain + lane;
    f32x4 v[4]; float s = 0.f;
#pragma unroll
    for (int j = 0; j < 4; ++j) { v[j] = xr[64 * j]; s += (v[j].x * v[j].x + v[j].y * v[j].y) + (v[j].z * v[j].z + v[j].w * v[j].w); }
    const float rstd = 1.f / sqrtf(wave_sum(s) * (1.f / 1024.f) + EPS);
    unsigned long long* o8 = (unsigned long long*)orow + lane;
#pragma unroll
    for (int j = 0; j < 4; ++j) { const f32x4 g = gr[64 * j]; o8[64 * j] = (unsigned long long)pk2(v[j].x * rstd * g.x, v[j].y * rstd * g.y) | ((unsigned long long)pk2(v[j].z * rstd * g.z, v[j].w * rstd * g.w) << 32); }
}
__device__ __forceinline__ void p0_prologue(Frame& F) {
    LAS float* scr = (LAS float*)(F.lds + F.wave * 16384);
    const int gw = F.vcu * NWAVES + F.wave, NGW = F.G * NWAVES, lane = F.lane;
    constexpr int N_IN = 16 * 49, N_QUP = 12 * 24, N_KVUP = 4 * 32, N_GLU = 8 * 16, N_SQ = 16 * 32, N_GU1 = 16 * 8, N_D1 = 4 * 32;
    constexpr int NITEMS = N_IN + N_QUP + N_KVUP + N_GLU + 5 * N_SQ + 64 * N_GU1 + 32 * N_D1;
    for (int it = gw; it < NITEMS; it += NGW) {
        int r = it;
        if (r < N_IN) { tr_item(F.f(I_WIN), DIN, F.wt(WT_IN), 1024, 64 * (r / 49), 32 * (r % 49), 32 * (r % 49), nullptr, nullptr, scr, lane); continue; } r -= N_IN;
        if (r < N_QUP) { tr_item(F.f(I_WQUP), 768, F.wt(WT_QUP), 768, 64 * (r / 24), 32 * (r % 24), 32 * (r % 24), F.f(I_GQ), nullptr, scr, lane); continue; } r -= N_QUP;
        if (r < N_KVUP) { tr_item(F.f(I_WKVUP), 1024, F.wt(WT_KVUP), 256, 64 * (r / 32), 32 * (r % 32), 32 * (r % 32), F.f(I_GKV), nullptr, scr, lane); continue; } r -= N_KVUP;
        if (r < N_GLU) { tr_item(F.f(I_WGLU), 512, F.wt(WT_GLU), 512, 64 * (r / 16), 32 * (r % 16), 32 * (r % 16), nullptr, nullptr, scr, lane); continue; } r -= N_GLU;
        if (r < 5 * N_SQ) { const int w = r / N_SQ, q = r % N_SQ; const int k0 = 64 * (q / 32), n0 = 32 * (q % 32);
            if (w == 0) tr_item(F.f(I_WOUT), 1024, F.wt(WT_OUT), 1024, k0, n0, n0, F.f(I_GSSM), F.f(I_GMLA), scr, lane);
            else if (w == 1) tr_item(F.f(I_XWQ), 1024, F.wt(WT_XQ), 1024, k0, n0, n0, F.f(I_GX), nullptr, scr, lane);
            else if (w == 2) tr_item(F.f(I_XWK), 1024, F.wt(WT_XK), 1024, k0, n0, n0, nullptr, nullptr, scr, lane);
            else if (w == 3) tr_item(F.f(I_XWV), 1024, F.wt(WT_XV), 1024, k0, n0, n0, nullptr, nullptr, scr, lane);
            else tr_item(F.f(I_XWO), 1024, F.wt(WT_XO), 1024, k0, n0, n0, nullptr, nullptr, scr, lane);
            continue; } r -= 5 * N_SQ;
        if (r < 64 * N_GU1) { const int mi = r / N_GU1, q = r % N_GU1, e = mi >> 1, up = mi & 1; const int k0 = 64 * (q / 8), n0 = 32 * (q % 8);
            const float* W = F.f(up ? I_WUP : I_WGATE) + (size_t)e * 1024 * 256;
            tr_item(W, 256, F.wt(WT_GU) + (size_t)e * 512 * 1024, 1024, k0, n0, (n0 >> 7) * 256 + up * 128 + (n0 & 127), nullptr, nullptr, scr, lane); continue; } r -= 64 * N_GU1;
        { const int e = r / N_D1, q = r % N_D1; const int k0 = 64 * (q / 32), n0 = 32 * (q % 32);
            tr_item(F.f(I_WDOWN) + (size_t)e * 256 * 1024, 1024, F.wt(WT_D) + (size_t)e * 1024 * 256, 256, k0, n0, n0, nullptr, nullptr, scr, lane); }
    }
    { u32x4* p = (u32x4*)(F.wt(WT_IN) + (size_t)DIN * 1024); const int n16 = (ZP - DIN) * 1024 * 2 / 16; const int gt = gw * 64 + lane;
        for (int i = gt; i < n16; i += NGW * 64) p[i] = (u32x4){0u, 0u, 0u, 0u}; }
    bf16_t* XN = (bf16_t*)(F.ws + WS_A); bf16_t* MEMN = (bf16_t*)(F.ws + WS_MEMN);
    for (int m = gw; m < T + 1024; m += NGW) {
        if (m < T) rms_row_to_bf16(F.f(I_X) + (size_t)m * 1024, F.f(I_GMIX), XN + (size_t)m * 1024, lane);
        else rms_row_to_bf16(F.f(I_MEM) + (size_t)(m - T) * 1024, F.f(I_GMEM), MEMN + (size_t)(m - T) * 1024, lane);
    }
    { f32x2* rope = (f32x2*)(F.ws + WS_ROPE); const int* pos = (const int*)F.in[I_POS]; const int gt = gw * 64 + lane;
        for (int i = gt; i < T * 16; i += NGW * 64) { const int t = i >> 4, k = i & 15;
            const float inv = powf(10000.f, -(float)k / 16.f); const float ang = (float)pos[t] * inv;
            rope[i] = (f32x2){(float)cos((double)ang), (float)sin((double)ang)}; } }
    { unsigned char* tab = F.ws + WS_TAB; f32x2* abar = (f32x2*)(tab + TAB_ABAR); f32x2* a256 = (f32x2*)(tab + TAB_A256);
        bf16_t* BBT = (bf16_t*)(tab + TAB_BBT); bf16_t* CCT = (bf16_t*)(tab + TAB_CCT); bf16_t* WRH = (bf16_t*)(tab + TAB_WRH); bf16_t* WRL = (bf16_t*)(tab + TAB_WRL);
        const int gt = gw * 64 + lane;
        if (gt < 2048) { const int g = gt >> 6, p = gt & 63;
            const double lre = fmin((double)F.f(I_LRE)[gt], -1e-4), lim = (double)F.f(I_LIM)[gt], dt = exp((double)F.f(I_LDT)[g]);
            const double zr = lre * dt, zi = lim * dt; const double er = exp(zr); const double ar = er * cos(zi), ai = er * sin(zi);
            abar[gt] = (f32x2){(float)ar, (float)ai};
            const double e2 = exp(256.0 * zr); a256[gt] = (f32x2){(float)(e2 * cos(256.0 * zi)), (float)(e2 * sin(256.0 * zi))};
            const double den = lre * lre + lim * lim; const double cr = ((ar - 1.0) * lre + ai * lim) / den, ci = (ai * lre - (ar - 1.0) * lim) / den;
            const int blk = 2 * (p >> 5), j = p & 31;
            for (int h = 0; h < 16; ++h) { const double br = (double)F.f(I_BRE)[(size_t)gt * 16 + h], bi = (double)F.f(I_BIM)[(size_t)gt * 16 + h];
                BBT[(size_t)(g * 128 + blk * 32 + j) * 16 + h] = (bf16_t)f2bf((float)(cr * br - ci * bi));
                BBT[(size_t)(g * 128 + (blk + 1) * 32 + j) * 16 + h] = (bf16_t)f2bf((float)(cr * bi + ci * br)); }
            for (int h = 0; h < 32; ++h) { float vr = 0.f, vi = 0.f;
                if (h < 16) { vr = F.f(I_CRE)[(size_t)(g * 16 + h) * 64 + p]; vi = -F.f(I_CIM)[(size_t)(g * 16 + h) * 64 + p]; }
                CCT[(size_t)(g * 32 + h) * 128 + blk * 32 + j] = (bf16_t)f2bf(vr); CCT[(size_t)(g * 32 + h) * 128 + (blk + 1) * 32 + j] = (bf16_t)f2bf(vi); } }
        for (int i = gt; i < 64 * 1024; i += NGW * 64) { const int n = i >> 10, k = i & 1023; float w = 0.f;
            if (n < 4) w = F.f(I_WGRP)[(size_t)k * 4 + n]; else if (n < 36) w = F.f(I_WEXP)[(size_t)k * 32 + (n - 4)];
            const unsigned hb = f2bf(w); WRH[i] = (bf16_t)hb; WRL[i] = (bf16_t)f2bf(w - bf2f((unsigned short)hb)); } }
}

__device__ __forceinline__ void router_phase(Frame& F, unsigned* cnt, unsigned char* lbase) {
    const int lane = F.lane, w = F.wave, r32 = lane & 31, hi = lane >> 5;
    for (int tb = F.vcu * 64; tb < T; tb += F.G * 64) {
    const float* x2 = F.out; const float* g3 = F.f(I_GMOE);
    bf16_t* XN3 = (bf16_t*)(F.ws + WS_Z);
    const bf16_t* WRH = (const bf16_t*)(F.ws + WS_TAB + TAB_WRH); const bf16_t* WRL = (const bf16_t*)(F.ws + WS_TAB + TAB_WRL);
    LAS float* part = (LAS float*)F.lds;
    LAS float* ssp = (LAS float*)(F.lds + 81920);
    f32x16 acc[2][2]; acc[0][0] = f32x16{}; acc[0][1] = f32x16{}; acc[1][0] = f32x16{}; acc[1][1] = f32x16{};
    float ss0 = 0.f, ss1 = 0.f;
#pragma unroll 2
    for (int s = 0; s < 8; ++s) { const int k = w * 128 + s * 16 + hi * 8;
        const f32x4 ga = *(const f32x4*)(g3 + k), gb = *(const f32x4*)(g3 + k + 4);
        bf16x8 wh[2], wl[2];
#pragma unroll
        for (int nb = 0; nb < 2; ++nb) { wh[nb] = *(const bf16x8*)(WRH + (size_t)(nb * 32 + r32) * 1024 + k); wl[nb] = *(const bf16x8*)(WRL + (size_t)(nb * 32 + r32) * 1024 + k); }
#pragma unroll
        for (int tq = 0; tq < 2; ++tq) { const size_t tok = (size_t)tb + tq * 32 + r32;
            const f32x4 xa = *(const f32x4*)(x2 + tok * 1024 + k), xb = *(const f32x4*)(x2 + tok * 1024 + k + 4);
            const float sq = (xa[0] * xa[0] + xa[1] * xa[1]) + (xa[2] * xa[2] + xa[3] * xa[3]) + (xb[0] * xb[0] + xb[1] * xb[1]) + (xb[2] * xb[2] + xb[3] * xb[3]);
            if (tq == 0) ss0 += sq; else ss1 += sq;
            const f32x4 va = xa * ga, vb = xb * gb;
            u32x4 h; h.x = pk2(va[0], va[1]); h.y = pk2(va[2], va[3]); h.z = pk2(vb[0], vb[1]); h.w = pk2(vb[2], vb[3]);
            *(u32x4*)(XN3 + tok * 1024 + k) = h;
            u32x4 l; l.x = pk2(va[0] - bflo(h.x), va[1] - bfhi(h.x)); l.y = pk2(va[2] - bflo(h.y), va[3] - bfhi(h.y)); l.z = pk2(vb[0] - bflo(h.z), vb[1] - bfhi(h.z)); l.w = pk2(vb[2] - bflo(h.w), vb[3] - bfhi(h.w));
            const bf16x8 bh = __builtin_bit_cast(bf16x8, h), bl = __builtin_bit_cast(bf16x8, l);
#pragma unroll
            for (int nb = 0; nb < 2; ++nb) {
                acc[tq][nb] = __builtin_amdgcn_mfma_f32_32x32x16_bf16(wh[nb], bh, acc[tq][nb], 0, 0, 0);
                acc[tq][nb] = __builtin_amdgcn_mfma_f32_32x32x16_bf16(wh[nb], bl, acc[tq][nb], 0, 0, 0);
                acc[tq][nb] = __builtin_amdgcn_mfma_f32_32x32x16_bf16(wl[nb], bh, acc[tq][nb], 0, 0, 0); } } }
#pragma unroll
    for (int tq = 0; tq < 2; ++tq) {
#pragma unroll
        for (int r = 0; r < 16; ++r) { const int n = (r & 3) + 8 * (r >> 2) + 4 * hi; part[(w * 64 + tq * 32 + r32) * 40 + n] = acc[tq][0][r]; }
        if (hi == 0) {
#pragma unroll
            for (int r = 0; r < 4; ++r) part[(w * 64 + tq * 32 + r32) * 40 + 32 + r] = acc[tq][1][r]; }
    }
    ss0 += __shfl_xor(ss0, 32); ss1 += __shfl_xor(ss1, 32);
    if (hi == 0) { ssp[w * 64 + r32] = ss0; ssp[w * 64 + 32 + r32] = ss1; }
    asm volatile("s_waitcnt lgkmcnt(0)" ::: "memory");
    __syncthreads();
    if (w == 0) {
        const int tok = tb + lane;
        float ss = 0.f;
#pragma unroll
        for (int k = 0; k < 8; ++k) ss += ssp[k * 64 + lane];
        const float rstd = 1.f / sqrtf(ss * (1.f / 1024.f) + EPS);
        float gl[4];
#pragma unroll
        for (int n = 0; n < 4; ++n) { float a = 0.f;
#pragma unroll
            for (int k = 0; k < 8; ++k) a += part[(k * 64 + lane) * 40 + n];
            gl[n] = a * rstd + F.f(I_BGRP)[n]; }
        int gi = 0; float gm = gl[0];
#pragma unroll
        for (int n = 1; n < 4; ++n) if (gl[n] > gm) { gm = gl[n]; gi = n; }
        float gsum = 0.f;
#pragma unroll
        for (int n = 0; n < 4; ++n) gsum += __expf(gl[n] - gm);
        const float gw_ = 1.f / gsum;
        float el[8];
#pragma unroll
        for (int j = 0; j < 8; ++j) { float a = 0.f;
#pragma unroll
            for (int k = 0; k < 8; ++k) a += part[(k * 64 + lane) * 40 + 4 + gi * 8 + j];
            el[j] = a * rstd + F.f(I_BEXP)[gi * 8 + j]; }
        int i0 = 0; float v0 = el[0];
#pragma unroll
        for (int j = 1; j < 8; ++j) if (el[j] > v0) { v0 = el[j]; i0 = j; }
        int i1 = -1; float v1 = -3.0e38f;
#pragma unroll
        for (int j = 0; j < 8; ++j) if (j != i0 && el[j] > v1) { v1 = el[j]; i1 = j; }
        const float w0 = 1.f / (1.f + __expf(v1 - v0)), w1 = 1.f - w0;
        const int e0 = gi * 8 + i0, e1 = gi * 8 + i1;
        int pos0 = 0, pos1 = 0; unsigned mycount = 0u;
        const unsigned long long lt = (1ull << lane) - 1ull;
        for (int e = 0; e < NEXP; ++e) {
            const unsigned long long m0 = __ballot(e0 == e), m1 = __ballot(e1 == e);
            const int c0 = __popcll(m0), c1 = __popcll(m1);
            if (lane == e) mycount = (unsigned)(c0 + c1);
            if (e0 == e) pos0 = __popcll(m0 & lt);
            if (e1 == e) pos1 = c0 + __popcll(m1 & lt);
        }
        unsigned mybase = 0u; if (lane < NEXP && mycount) mybase = atomicAdd(cnt + lane, mycount);
        pos0 += (int)__shfl(mybase, e0); pos1 += (int)__shfl(mybase, e1);
        int* list = (int*)(lbase); int* listd = (int*)(lbase + (WS_LISTD - WS_LIST)); float* listw = (float*)(lbase + (WS_LISTW - WS_LIST));
        list[e0 * LCAP + pos0] = tok; listd[e0 * LCAP + pos0] = tok * 2; listw[e0 * LCAP + pos0] = w0 * gw_;
        list[e1 * LCAP + pos1] = tok; listd[e1 * LCAP + pos1] = tok * 2 + 1; listw[e1 * LCAP + pos1] = w1 * gw_;
        float* rstd3 = (float*)(F.ws + WS_TOKI); rstd3[tok] = rstd;
        int* tinfo = (int*)(F.ws + WS_TOKI + 65536); tinfo[tok * 4 + 0] = e0; tinfo[tok * 4 + 1] = e1; tinfo[tok * 4 + 2] = pos0; tinfo[tok * 4 + 3] = pos1;
        float* tokw = (float*)(F.ws + WS_TOKI + 65536 + 262144); tokw[tok * 2] = w0 * gw_; tokw[tok * 2 + 1] = w1 * gw_;
    }
    __syncthreads();
    }
}

__device__ __forceinline__ void final_phase(Frame& F, float* outp) {
    const int gw = F.vcu * NWAVES + F.wave, NGW = F.G * NWAVES, lane = F.lane;
    const bf16_t* ymoe = (const bf16_t*)(F.ws + WS_YMOE); const f32x4* gr = (const f32x4*)F.f(I_GFIN) + lane;
    for (int m = gw; m < T; m += NGW) {
        const f32x4* xr = (const f32x4*)(F.out + (size_t)m * 1024) + lane; f32x4* xo = (f32x4*)(outp + (size_t)m * 1024) + lane;
        const u32x2* y0 = (const u32x2*)(ymoe + (size_t)(2 * m) * 1024) + lane; const u32x2* y1 = (const u32x2*)(ymoe + (size_t)(2 * m + 1) * 1024) + lane;
        f32x4 v[4]; float s = 0.f;
#pragma unroll
        for (int j = 0; j < 4; ++j) { v[j] = xr[64 * j]; const u32x2 a = y0[64 * j], b = y1[64 * j];
            v[j].x += bflo(a.x) + bflo(b.x); v[j].y += bfhi(a.x) + bfhi(b.x); v[j].z += bflo(a.y) + bflo(b.y); v[j].w += bfhi(a.y) + bfhi(b.y);
            s += (v[j].x * v[j].x + v[j].y * v[j].y) + (v[j].z * v[j].z + v[j].w * v[j].w); }
        float rstd = 1.f / sqrtf(wave_sum(s) * (1.f / 1024.f) + EPS);
#if TIMING_PROBE
        { const unsigned long long* ts = (const unsigned long long*)(F.ws + WS_TOKI + 786432); rstd *= 1.f + (float)(ts[TS_B] - ts[TS_A]) * 0.01f / (float)TS_SCALE; }
#endif
#pragma unroll
        for (int j = 0; j < 4; ++j) xo[64 * j] = v[j] * rstd * gr[64 * j];
    }
}

#if DEBUG_HYBRID
namespace nv {
template <class E>
__global__ __launch_bounds__(256) void gemm(const bf16_t* A, int lda, const bf16_t* Bt, int ldb, int K, E e) {
    __shared__ float As[16][65], Bs[16][65];
    const int tx = threadIdx.x & 15, ty = threadIdx.x >> 4, m0 = blockIdx.y * 64, n0 = blockIdx.x * 64;
    float acc[4][4] = {};
    for (int k0 = 0; k0 < K; k0 += 16) {
        for (int i = 0; i < 4; ++i) { const int idx = threadIdx.x + 256 * i, r = idx >> 4, kk = idx & 15;
            As[kk][r] = bf2f(A[(size_t)(m0 + r) * lda + k0 + kk]); Bs[kk][r] = bf2f(Bt[(size_t)(n0 + r) * ldb + k0 + kk]); }
        __syncthreads();
        for (int kk = 0; kk < 16; ++kk) { float a[4], b[4];
            for (int i = 0; i < 4; ++i) { a[i] = As[kk][ty + 16 * i]; b[i] = Bs[kk][tx + 16 * i]; }
            for (int i = 0; i < 4; ++i) for (int j = 0; j < 4; ++j) acc[i][j] += a[i] * b[j]; }
        __syncthreads();
    }
    for (int i = 0; i < 4; ++i) e(m0 + ty + 16 * i, n0, tx, acc[i]);
}
struct EZ { bf16_t* z; ss_t* ssq; ss_t* sskv; bf16_t* kpe; const f32x2* rope;
    __device__ void operator()(int row, int n0, int tx, const float (&v)[4]) const {
        if (n0 < 1536) { float s = 0.f; for (int j = 0; j < 4; ++j) { z[(size_t)row * ZP + n0 + tx + 16 * j] = (bf16_t)f2bf(v[j]); s += v[j] * v[j]; }
            if (n0 >= 512 && n0 < 1280) ss_add(ssq + row, s); else if (n0 >= 1280) ss_add(sskv + row, s); }
        else if (n0 == 1536) { const f32x2 cs = rope[(size_t)row * 16 + tx];
            kpe[(size_t)row * 32 + tx] = (bf16_t)f2bf(v[0] * cs.x - v[1] * cs.y); kpe[(size_t)row * 32 + 16 + tx] = (bf16_t)f2bf(v[0] * cs.y + v[1] * cs.x); } } };
struct EStore { bf16_t* O; int ldc;
    __device__ void operator()(int row, int n0, int tx, const float (&v)[4]) const { for (int j = 0; j < 4; ++j) O[(size_t)row * ldc + n0 + tx + 16 * j] = (bf16_t)f2bf(v[j]); } };
struct EVXT { bf16_t* O;
    __device__ void operator()(int row, int n0, int tx, const float (&v)[4]) const { for (int j = 0; j < 4; ++j) { const int n = n0 + tx + 16 * j; O[(size_t)(n >> 8) * 262144 + (size_t)row * 256 + (n & 255)] = (bf16_t)f2bf(v[j]); } } };
struct EQ { bf16_t* q; const ss_t* ssq; const f32x2* rope;
    __device__ void operator()(int row, int n0, int tx, const float (&v)[4]) const {
        const float rs = 1.f / sqrtf(ss_get(ssq + row) * (1.f / 768.f) + EPS) * QS; float o[4];
        for (int j = 0; j < 4; ++j) o[j] = v[j] * rs;
        for (int hh = 0; hh < 2; ++hh) { const int g32 = n0 / 32 + hh; if (g32 % 3 == 2) { const f32x2 cs = rope[(size_t)row * 16 + tx]; const float a = o[2 * hh], b = o[2 * hh + 1];
            o[2 * hh] = a * cs.x - b * cs.y; o[2 * hh + 1] = a * cs.y + b * cs.x; } }
        for (int j = 0; j < 4; ++j) q[(size_t)row * 768 + n0 + tx + 16 * j] = (bf16_t)f2bf(o[j]); } };
struct EKV { bf16_t* kv; const ss_t* sskv;
    __device__ void operator()(int row, int n0, int tx, const float (&v)[4]) const { const float rs = 1.f / sqrtf(ss_get(sskv + row) * (1.f / 256.f) + EPS);
        for (int j = 0; j < 4; ++j) kv[(size_t)row * 1024 + n0 + tx + 16 * j] = (bf16_t)f2bf(v[j] * rs); } };
struct EGLU { const bf16_t* yg; const float* bias; bf16_t* y; ss_t* ss;
    __device__ void operator()(int row, int n0, int tx, const float (&v)[4]) const { float s = 0.f;
        for (int j = 0; j < 4; ++j) { const int c = n0 + tx + 16 * j; const float o = bf2f(yg[(size_t)row * 512 + c]) * sigmoidf_(v[j] + bias[c]); s += o * o; y[(size_t)row * 1024 + c] = (bf16_t)f2bf(o); }
        ss_add(ss + row, s); } };
struct EOutA { const float* base; float* out; const ss_t* ss;
    __device__ void operator()(int row, int n0, int tx, const float (&v)[4]) const { const float rs = 1.f / sqrtf(ss_get(ss + row) * (1.f / 512.f) + EPS);
        for (int j = 0; j < 4; ++j) { const size_t o = (size_t)row * 1024 + n0 + tx + 16 * j; out[o] = base[o] + v[j] * rs; } } };
struct EOutB { float* out; bf16_t* xb; const ss_t* ss; ss_t* ssx;
    __device__ void operator()(int row, int n0, int tx, const float (&v)[4]) const { const float rs = 1.f / sqrtf(ss_get(ss + row) * (1.f / 512.f) + EPS); float s = 0.f;
        for (int j = 0; j < 4; ++j) { const size_t o = (size_t)row * 1024 + n0 + tx + 16 * j; const float x1 = out[o] + v[j] * rs; out[o] = x1; xb[o] = (bf16_t)f2bf(x1); s += x1 * x1; }
        ss_add(ssx + row, s); } };
struct EXQ { bf16_t* O; const ss_t* ss;
    __device__ void operator()(int row, int n0, int tx, const float (&v)[4]) const { const float rs = 1.f / sqrtf(ss_get(ss + row) * (1.f / 1024.f) + EPS) * XS;
        for (int j = 0; j < 4; ++j) O[(size_t)row * 1024 + n0 + tx + 16 * j] = (bf16_t)f2bf(v[j] * rs); } };
struct EAdd { float* out;
    __device__ void operator()(int row, int n0, int tx, const float (&v)[4]) const { for (int j = 0; j < 4; ++j) out[(size_t)row * 1024 + n0 + tx + 16 * j] += v[j]; } };

__global__ __launch_bounds__(64) void ssm_a(const bf16_t* z, const unsigned char* tab, float* Sc) {
    const int it = blockIdx.x, lane = threadIdx.x, c = it & 15, g = (it >> 4) & 31, b = it >> 9, p = lane;
    const f32x2 a = ((const f32x2*)(tab + TAB_ABAR))[g * 64 + p]; const bf16_t* BBT = (const bf16_t*)(tab + TAB_BBT);
    const int blk = 2 * (p >> 5), j = p & 31; float br[16], bi[16];
    for (int h = 0; h < 16; ++h) { br[h] = bf2f(BBT[(size_t)(g * 128 + blk * 32 + j) * 16 + h]); bi[h] = bf2f(BBT[(size_t)(g * 128 + (blk + 1) * 32 + j) * 16 + h]); }
    float xr = 0.f, xi = 0.f;
    for (int t = 0; t < 256; ++t) { const bf16_t* u = z + ((size_t)b * SEQ + c * 256 + t) * ZP + g * 16; float sr = 0.f, si = 0.f;
        for (int h = 0; h < 16; ++h) { const float uu = bf2f(u[h]); sr += br[h] * uu; si += bi[h] * uu; }
        const float nr = a.x * xr - a.y * xi + sr, ni = a.x * xi + a.y * xr + si; xr = nr; xi = ni; }
    Sc[(size_t)it * 128 + blk * 32 + j] = xr; Sc[(size_t)it * 128 + (blk + 1) * 32 + j] = xi;
}
__global__ __launch_bounds__(64) void ssm_c(const bf16_t* z, const unsigned char* tab, const float* dskip, bf16_t* yg) {
    const int g = blockIdx.x & 31, b = blockIdx.x >> 5, p = threadIdx.x;
    const f32x2 a = ((const f32x2*)(tab + TAB_ABAR))[g * 64 + p]; const bf16_t* BBT = (const bf16_t*)(tab + TAB_BBT); const bf16_t* CCT = (const bf16_t*)(tab + TAB_CCT);
    const int blk = 2 * (p >> 5), j = p & 31; float br[16], bi[16], cr[16], ci[16];
    for (int h = 0; h < 16; ++h) { br[h] = bf2f(BBT[(size_t)(g * 128 + blk * 32 + j) * 16 + h]); bi[h] = bf2f(BBT[(size_t)(g * 128 + (blk + 1) * 32 + j) * 16 + h]);
        cr[h] = bf2f(CCT[(size_t)(g * 32 + h) * 128 + blk * 32 + j]); ci[h] = bf2f(CCT[(size_t)(g * 32 + h) * 128 + (blk + 1) * 32 + j]); }
    float xr = 0.f, xi = 0.f;
    for (int t = 0; t < SEQ; ++t) { const size_t tok = (size_t)b * SEQ + t; const bf16_t* u = z + tok * ZP + g * 16; float sr = 0.f, si = 0.f, uu[16];
        for (int h = 0; h < 16; ++h) { uu[h] = bf2f(u[h]); sr += br[h] * uu[h]; si += bi[h] * uu[h]; }
        const float nr = a.x * xr - a.y * xi + sr, ni = a.x * xi + a.y * xr + si; xr = nr; xi = ni;
        for (int h = 0; h < 16; ++h) { const float yv = wave_sum(cr[h] * xr + ci[h] * xi);
            if (p == h) yg[tok * 512 + g * 16 + h] = (bf16_t)f2bf(gelu_tanh(yv + dskip[g * 16 + h] * uu[h])); } }
}
__global__ __launch_bounds__(64) void mla_attn(const bf16_t* q, const bf16_t* kv, const bf16_t* kpe, bf16_t* y, ss_t* ssm) {
    __shared__ float Ks[64][97], Vs[64][65];
    const int qc = blockIdx.x & 63, h = (blockIdx.x >> 6) & 7, b = blockIdx.x >> 9, tq = threadIdx.x;
    const size_t row = (size_t)b * SEQ + qc * 64 + tq;
    float qv[96], o[64]; for (int d = 0; d < 96; ++d) qv[d] = bf2f(q[row * 768 + h * 96 + d]); for (int d = 0; d < 64; ++d) o[d] = 0.f;
    float m = -1e30f, l = 0.f;
    for (int kt = 0; kt <= qc; ++kt) {
        __syncthreads();
        for (int i = threadIdx.x; i < 64 * 96; i += 64) { const int k = i / 96, d = i % 96; const size_t kr = (size_t)b * SEQ + kt * 64 + k;
            Ks[k][d] = d < 64 ? bf2f(kv[kr * 1024 + h * 128 + d]) : bf2f(kpe[kr * 32 + d - 64]); }
        for (int i = threadIdx.x; i < 64 * 64; i += 64) { const int k = i / 64, d = i % 64; Vs[k][d] = bf2f(kv[((size_t)b * SEQ + kt * 64 + k) * 1024 + h * 128 + 64 + d]); }
        __syncthreads();
        for (int k = 0; k < 64; ++k) { float s = 0.f; for (int d = 0; d < 96; ++d) s += qv[d] * Ks[k][d];
            const float mn = fmaxf(m, s), al = exp2f(m - mn), pp = exp2f(s - mn); l = l * al + pp; for (int d = 0; d < 64; ++d) o[d] = o[d] * al + pp * Vs[k][d]; m = mn; }
    }
    float s2 = 0.f; for (int d = 0; d < 64; ++d) { const float v = o[d] / l; s2 += v * v; y[row * 1024 + 512 + h * 64 + d] = (bf16_t)f2bf(v); }
    ss_add(ssm + row, s2);
}
__global__ __launch_bounds__(256) void xattn(const bf16_t* QX, const bf16_t* KX, const bf16_t* VXT, bf16_t* OX) {
    __shared__ float qs[256], ps[256], red[256];
    const int tok = blockIdx.x >> 2, h = blockIdx.x & 3, b = tok / SEQ, t = threadIdx.x;
    qs[t] = bf2f(QX[(size_t)tok * 1024 + h * 256 + t]); __syncthreads();
    float s = 0.f; const bf16_t* kr = KX + (size_t)(b * 256 + t) * 1024 + h * 256; for (int d = 0; d < 256; ++d) s += qs[d] * bf2f(kr[d]);
    red[t] = s; __syncthreads(); for (int o = 128; o > 0; o >>= 1) { if (t < o) red[t] = fmaxf(red[t], red[t + o]); __syncthreads(); }
    const float mx = red[0]; __syncthreads();
    const float p = exp2f(s - mx); ps[t] = bf2f((unsigned short)f2bf(p)); red[t] = p; __syncthreads(); for (int o = 128; o > 0; o >>= 1) { if (t < o) red[t] += red[t + o]; __syncthreads(); }
    const float l = red[0];
    float acc = 0.f; const bf16_t* vr = VXT + (size_t)b * 262144 + (size_t)(h * 256 + t) * 256; for (int k = 0; k < 256; ++k) acc += ps[k] * bf2f(vr[k]);
    OX[(size_t)tok * 1024 + h * 256 + t] = (bf16_t)f2bf(acc / l);
}
__global__ __launch_bounds__(256) void router(const float* x2, const float* g3, const float* wg, const float* bg, const float* we, const float* be, unsigned char* ws) {
    __shared__ float red[256]; __shared__ float lg[36];
    const int tok = blockIdx.x, t = threadIdx.x; float xv[4], hv[4]; float s = 0.f;
    for (int i = 0; i < 4; ++i) { xv[i] = x2[(size_t)tok * 1024 + t + 256 * i]; s += xv[i] * xv[i]; hv[i] = xv[i] * g3[t + 256 * i]; }
    red[t] = s; __syncthreads(); for (int o = 128; o > 0; o >>= 1) { if (t < o) red[t] += red[t + o]; __syncthreads(); }
    const float rstd = 1.f / sqrtf(red[0] * (1.f / 1024.f) + EPS); __syncthreads();
    bf16_t* XN3 = (bf16_t*)(ws + WS_Z); for (int i = 0; i < 4; ++i) XN3[(size_t)tok * 1024 + t + 256 * i] = (bf16_t)f2bf(hv[i]);
    for (int n = 0; n < 36; ++n) { float a = 0.f; for (int i = 0; i < 4; ++i) { const int k = t + 256 * i; a += hv[i] * (n < 4 ? wg[(size_t)k * 4 + n] : we[(size_t)k * 32 + n - 4]); }
        red[t] = a; __syncthreads(); for (int o = 128; o > 0; o >>= 1) { if (t < o) red[t] += red[t + o]; __syncthreads(); } if (t == 0) lg[n] = red[0] * rstd; __syncthreads(); }
    if (t == 0) { float gl[4]; for (int n = 0; n < 4; ++n) gl[n] = lg[n] + bg[n]; int gi = 0; float gm = gl[0]; for (int n = 1; n < 4; ++n) if (gl[n] > gm) { gm = gl[n]; gi = n; }
        float gs = 0.f; for (int n = 0; n < 4; ++n) gs += expf(gl[n] - gm); const float gw = 1.f / gs;
        float el[8]; for (int j = 0; j < 8; ++j) el[j] = lg[4 + gi * 8 + j] + be[gi * 8 + j];
        int i0 = 0; float v0 = el[0]; for (int j = 1; j < 8; ++j) if (el[j] > v0) { v0 = el[j]; i0 = j; }
        int i1 = -1; float v1 = -3.0e38f; for (int j = 0; j < 8; ++j) if (j != i0 && el[j] > v1) { v1 = el[j]; i1 = j; }
        const float w0 = 1.f / (1.f + expf(v1 - v0)), w1 = 1.f - w0; const int e0 = gi * 8 + i0, e1 = gi * 8 + i1;
        unsigned* cnt = (unsigned*)(ws + WS_CTL) + CW_CNT; const int pos0 = (int)atomicAdd(cnt + e0, 1u), pos1 = (int)atomicAdd(cnt + e1, 1u);
        int* list = (int*)(ws + WS_LIST); int* listd = (int*)(ws + WS_LISTD); float* listw = (float*)(ws + WS_LISTW);
        list[e0 * LCAP + pos0] = tok; listd[e0 * LCAP + pos0] = tok * 2; listw[e0 * LCAP + pos0] = w0 * gw;
        list[e1 * LCAP + pos1] = tok; listd[e1 * LCAP + pos1] = tok * 2 + 1; listw[e1 * LCAP + pos1] = w1 * gw;
        ((float*)(ws + WS_TOKI))[tok] = rstd; int* ti = (int*)(ws + WS_TOKI + 65536); ti[tok * 4] = e0; ti[tok * 4 + 1] = e1; ti[tok * 4 + 2] = pos0; ti[tok * 4 + 3] = pos1;
        float* tw = (float*)(ws + WS_TOKI + 65536 + 262144); tw[tok * 2] = w0 * gw; tw[tok * 2 + 1] = w1 * gw; }
}
__global__ __launch_bounds__(256) void moe_slot(unsigned char* ws) {
    __shared__ float hs[1024], av[256];
    const int tok = blockIdx.x >> 1, k = blockIdx.x & 1, t = threadIdx.x;
    const int e = ((const int*)(ws + WS_TOKI + 65536))[tok * 4 + k]; const float w = ((const float*)(ws + WS_TOKI + 65536 + 262144))[tok * 2 + k]; const float rstd = ((const float*)(ws + WS_TOKI))[tok];
    const bf16_t* XN3 = (const bf16_t*)(ws + WS_Z); for (int i = 0; i < 4; ++i) hs[t + 256 * i] = bf2f(XN3[(size_t)tok * 1024 + t + 256 * i]); __syncthreads();
    const bf16_t* WG = (const bf16_t*)(ws + WS_WT) + WT_GU + (size_t)e * 512 * 1024; const bf16_t* WD = (const bf16_t*)(ws + WS_WT) + WT_D + (size_t)e * 1024 * 256;
    const bf16_t* gr = WG + (size_t)((t >> 7) * 256 + (t & 127)) * 1024; const bf16_t* ur = gr + (size_t)128 * 1024; float g = 0.f, u = 0.f;
    for (int d = 0; d < 1024; ++d) { g += hs[d] * bf2f(gr[d]); u += hs[d] * bf2f(ur[d]); }
    g *= rstd; u *= rstd; av[t] = bf2f((unsigned short)f2bf(g * sigmoidf_(g) * u)); __syncthreads();
    bf16_t* ymoe = (bf16_t*)(ws + WS_YMOE);
    for (int i = 0; i < 4; ++i) { const int d = t + 256 * i; const bf16_t* dr = WD + (size_t)d * 256; float a = 0.f; for (int f = 0; f < 256; ++f) a += av[f] * bf2f(dr[f]);
        ymoe[(size_t)(tok * 2 + k) * 1024 + d] = (bf16_t)f2bf(a * w); }
}
__global__ __launch_bounds__(256) void final_rows(float* out, const bf16_t* ymoe, const float* g) {
    __shared__ float red[256]; const int tok = blockIdx.x, t = threadIdx.x; float v[4]; float s = 0.f;
    for (int i = 0; i < 4; ++i) { const int c = t + 256 * i; v[i] = out[(size_t)tok * 1024 + c] + bf2f(ymoe[(size_t)(2 * tok) * 1024 + c]) + bf2f(ymoe[(size_t)(2 * tok + 1) * 1024 + c]); s += v[i] * v[i]; }
    red[t] = s; __syncthreads(); for (int o = 128; o > 0; o >>= 1) { if (t < o) red[t] += red[t + o]; __syncthreads(); }
    const float rstd = 1.f / sqrtf(red[0] * (1.f / 1024.f) + EPS);
    for (int i = 0; i < 4; ++i) { const int c = t + 256 * i; out[(size_t)tok * 1024 + c] = v[i] * rstd * g[c]; }
}
}
#endif

constexpr int NPHASE = 12;
__global__ void __launch_bounds__(NWAVES * 64, 2) mega_fwd(Args args) {
    extern __shared__ __attribute__((aligned(16))) unsigned char lds_raw[];
    Frame F;
    F.lds = (LAS unsigned char*)lds_raw; F.ws = args.ws; F.out = args.out; F.in = args.in;
    F.tid = threadIdx.x; F.lane = F.tid & 63; F.wave = __builtin_amdgcn_readfirstlane(F.tid >> 6);
    F.G = gridDim.x; { const int bx = blockIdx.x; F.vcu = (F.G % 8 == 0) ? (bx % 8) * (F.G / 8) + bx / 8 : bx; }
    volatile LAS unsigned* MISC = (volatile LAS unsigned*)(F.lds + MISC_OFF);
    for (int u = F.tid; u < (LDS_BYTES - LDSCTL_OFF) / 4; u += NWAVES * 64) ((LAS unsigned*)(F.lds + LDSCTL_OFF))[u] = 0u;
    __syncthreads();
    const int lo = args.ph_lo, hi = args.ph_hi;
    unsigned* ctl = (unsigned*)(F.ws + WS_CTL);
    XcdBarrier bar; bar.bar = ctl + CW_BAR + args.li * XCD_BAR_WORDS; bar.x = 0; bar.st = nullptr;
    if (hi - lo > 1) bar = xcd_barrier_post(ctl + CW_BAR + args.li * XCD_BAR_WORDS, MISC + 8);
#ifndef PHASE_ENABLE
#define PHASE_ENABLE 0xFFF
#endif
#define IN(k) (((PHASE_ENABLE >> (k)) & 1) && lo <= (k) && (k) < hi)
#ifndef TIMING_PROBE
#define TIMING_PROBE 0
#endif
#if TIMING_PROBE
#define STAMP(k) do { if (blockIdx.x == 0 && F.tid == 0) ((unsigned long long*)(F.ws + WS_TOKI + 786432))[(k)] = __builtin_amdgcn_s_memrealtime(); } while (0)
#else
#define STAMP(k) do {} while (0)
#endif
#define SEAM(k) do { if (IN(k) && IN((k) + 1)) xcd_barrier(bar); STAMP((k) + 1); } while (0)
    unsigned char* ws = F.ws; const int c = (int)blockIdx.x, G = F.G;
#define XN ((bf16_t*)(ws + WS_A))
#define Y ((bf16_t*)(ws + WS_A))
#define OX ((bf16_t*)(ws + WS_A))
#define Z ((bf16_t*)(ws + WS_Z))
#define X1B ((bf16_t*)(ws + WS_Z))
#define XN3 ((bf16_t*)(ws + WS_Z))
#define QX ((bf16_t*)(ws + WS_QX))
#define H1 ((bf16_t*)(ws + WS_QX))
#define Q ((bf16_t*)(ws + WS_Q))
#define PB ((bf16_t*)(ws + WS_PB))
#define KV ((bf16_t*)(ws + WS_KV))
#define KPE ((bf16_t*)(ws + WS_KPE))
#define YG ((bf16_t*)(ws + WS_YG))
#define YMOE ((bf16_t*)(ws + WS_YMOE))
#define MEMN ((bf16_t*)(ws + WS_MEMN))
#define KX ((bf16_t*)(ws + WS_KX))
#define VXT ((bf16_t*)(ws + WS_VXT))
#define ROPE ((const f32x2*)(ws + WS_ROPE))
#define SC ((float*)(ws + WS_SC))
#define ABAR ((const f32x2*)(ws + WS_TAB + TAB_ABAR))
#define A256 ((const f32x2*)(ws + WS_TAB + TAB_A256))
#define BBT ((const bf16_t*)(ws + WS_TAB + TAB_BBT))
#define CCT ((const bf16_t*)(ws + WS_TAB + TAB_CCT))
#define SSQ (F.ctlf(CW_SSQ))
#define SSKV (F.ctlf(CW_SSKV))
#define SSMLA (F.ctlf(CW_SSMLA))
#define SSSSM (F.ctlf(CW_SSSSM))
#define SSX1 (F.ctlf(CW_SSX1))
#define LROW ((float*)(ws + WS_TOKI + 524288))

#ifndef DUP_MASK
#define DUP_MASK 0
#endif
#define DUPLOOP(k)
#define DRY (args.dry != 0)
#define DRYBAR do {} while (0)
#define DUMMY (ws + 244 * MiB)
    STAMP(0);
    if (IN(0)) { DUPLOOP(0) { p0_prologue(F); DRYBAR; } SEAM(0); }

    if (IN(1)) { DUPLOOP(1) {
        { pg8::ProbDense P{XN, F.wt(WT_IN), 1024, 1024, 1024, {}}; P.O.init(T / 256, ZP / 256, G, c);
          epi::EpiZ E{Z, DRY ? (ss_t*)DUMMY : SSQ, DRY ? (ss_t*)DUMMY : SSKV, KPE, ROPE}; pg8::gemm_phase<epi::EpiZ, pg8::ProbDense, true>(F.lds, P, E); }
        const int c2 = (c + 64) % G;
        { pg8::ProbDense P{MEMN, F.wt(WT_XK), 1024, 1024, 1024, {}}; P.O.init(4, 4, G, c2);
          epi::EpiStore E{KX, 1024}; pg8::gemm_phase<epi::EpiStore, pg8::ProbDense, true>(F.lds, P, E); }
        { pg8::ProbDense P{F.wt(WT_XV), MEMN, 1024, 1024, 1024, {}}; P.O.init(4, 4, G, c2 - 16);
          epi::EpiVXT E{VXT}; pg8::gemm_phase<epi::EpiVXT, pg8::ProbDense, true>(F.lds, P, E); }
        DRYBAR; }
        SEAM(1);
    }

    if (IN(2)) { DUPLOOP(2) {
        for (int it = F.vcu * NWAVES + F.wave; it < 2048; it += G * NWAVES)
            ssm::item<false>(it, Z, ABAR, A256, BBT, CCT, F.f(I_SD), SC, YG, (LAS bf16_t*)(F.lds + F.wave * 16384), F.lane);
        __syncthreads();
        { pg8::ProbDense P{Z + 1280, F.wt(WT_KVUP), ZP, 256, 256, {}}; P.O.init(T / 256, 4, G, c);
          epi::EpiKV E{KV, SSKV}; pg8::gemm_phase<epi::EpiKV, pg8::ProbDense, true>(F.lds, P, E); }
        { pg8::ProbDense P{Z + 512, F.wt(WT_QUP), ZP, 768, 768, {}}; P.O.init(T / 256, 3, G, c);
          epi::EpiQ E{Q, SSQ, ROPE}; pg8::gemm_phase<epi::EpiQ, pg8::ProbDense, true>(F.lds, P, E); }
        DRYBAR; }
        SEAM(2);
    }

    if (IN(3)) { DUPLOOP(3) {
#ifndef NO_SSMC
        for (int it = F.vcu * NWAVES + F.wave; it < 2048; it += G * NWAVES)
            ssm::item<true>(it, Z, ABAR, A256, BBT, CCT, F.f(I_SD), SC, YG, (LAS bf16_t*)(F.lds + F.wave * 16384), F.lane);
#endif
        __syncthreads();
#ifndef NO_MLA
        for (int v = F.vcu; v < 256; v += G) { const int bh = v >> 3, s = v & 7;
            mla::unit(bh >> 3, bh & 7, s, Q, KV, KPE, Y, DRY ? (ss_t*)DUMMY : SSMLA, (char*)lds_raw);
            mla::unit(bh >> 3, bh & 7, 15 - s, Q, KV, KPE, Y, DRY ? (ss_t*)DUMMY : SSMLA, (char*)lds_raw); }
#endif
        DRYBAR; }
        SEAM(3);
    }

    if (IN(4)) { DUPLOOP(4) {
        { pg8::ProbDense P{YG, F.wt(WT_GLU), 512, 512, 512, {}}; P.O.init(T / 256, 2, G, c);
          epi::EpiGLU E{YG, F.f(I_BGLU), Y, DRY ? (ss_t*)DUMMY : SSSSM}; pg8::gemm_phase<epi::EpiGLU, pg8::ProbDense, true>(F.lds, P, E); }
        DRYBAR; }
        SEAM(4);
    }

    if (IN(5)) { DUPLOOP(5) {
        { pg8::ProbDense P{Y, F.wt(WT_OUT), 1024, 1024, 1024, {}}; P.O.init(T / 256, 4, G, c);
          epi::EpiOut E{F.f(I_X), F.out, X1B, SSSSM, SSMLA, DRY ? (ss_t*)DUMMY : SSX1}; pg8::gemm_phase<epi::EpiOut, pg8::ProbDense, true>(F.lds, P, E); }
        DRYBAR; }
        SEAM(5);
    }

    if (IN(6)) { DUPLOOP(6) {
        pg8::GridOrder O; O.init(T / 256, 4, G, c);
        int pm, h;
        for (int i = 0; O.get(i, pm, h); ++i) { const int b = pm / 16;
            { pg8::ProbOne P{X1B + (size_t)pm * 256 * 1024, F.wt(WT_XQ) + (size_t)h * 256 * 1024, 1024, 1024, 1024, pm, h};
              epi::EpiXQ E{QX, SSX1}; pg8::gemm_phase<epi::EpiXQ, pg8::ProbOne, false>(F.lds, P, E); }
            cu_sync_global();
            { pg8::ProbOne P{QX + (size_t)pm * 256 * 1024 + h * 256, KX + (size_t)b * 256 * 1024 + h * 256, 1024, 1024, 256, pm, h};
              epi::EpiSoft E{PB, LROW}; pg8::gemm_phase<epi::EpiSoft, pg8::ProbOne, false>(F.lds, P, E); }
            cu_sync_global();
            { pg8::ProbOne P{PB + (size_t)pm * 256 * 1024 + h * 256, VXT + (size_t)b * 262144 + (size_t)h * 256 * 256, 1024, 256, 256, pm, h};
              epi::EpiPV E{OX, LROW}; pg8::gemm_phase<epi::EpiPV, pg8::ProbOne, false>(F.lds, P, E); }
        }
        DRYBAR; }
        SEAM(6);
    }

    if (IN(7)) { DUPLOOP(7) {
        { pg8::ProbDense P{OX, F.wt(WT_XO), 1024, 1024, 1024, {}}; P.O.init(T / 256, 4, G, c);
          epi::EpiAdd E{F.out, DRY ? (float*)(ws + WS_QX) : F.out}; pg8::gemm_phase<epi::EpiAdd, pg8::ProbDense, true>(F.lds, P, E); }
        DRYBAR; }
        SEAM(7);
    }

    if (IN(8)) { DUPLOOP(8) { router_phase(F, (unsigned*)(ws + WS_CTL) + CW_CNT + (DRY ? 64 : 0), DRY ? DUMMY + MiB : ws + WS_LIST); DRYBAR; } SEAM(8); }

    if (IN(9) || IN(10)) {
        LAS int* tmap = (LAS int*)(F.lds + TMAP_OFF); volatile LAS int* nt_l = (volatile LAS int*)(F.lds + TMAP_OFF + 1024);
        const unsigned* cnt = (const unsigned*)(ws + WS_CTL) + CW_CNT;
        if (F.tid == 0) { int j = 0; for (int e = 0; e < NEXP; ++e) { const int n = (int)__hip_atomic_load(cnt + e, RLX_AGENT); const int nr = (n + 255) >> 8; for (int r = 0; r < nr && j < 192; ++r) tmap[j++] = e | (r << 8); } nt_l[0] = j; }
        __syncthreads();
        moe::Ctx X{tmap, (int)nt_l[0], cnt, (const int*)(ws + WS_LIST), (const int*)(ws + WS_LISTD), (const float*)(ws + WS_LISTW), (const float*)(ws + WS_TOKI)};
        if (IN(9)) { DUPLOOP(9) { moe::ProbGU P{XN3, F.wt(WT_GU), 1024, X, G, c}; moe::EpiGU E{H1, X}; pg8::gemm_phase<moe::EpiGU, moe::ProbGU, true>(F.lds, P, E); DRYBAR; } SEAM(9); }
        if (IN(10)) { int nk4 = 4; asm volatile("" : "+s"(nk4)); moe::ProbD P{H1, F.wt(WT_D), 256, X, G, c, nk4}; DUPLOOP(10) { moe::EpiD E{YMOE, X}; pg8::gemm_phase<moe::EpiD, moe::ProbD, true>(F.lds, P, E); DRYBAR; } SEAM(10); }
    }

    if (IN(11)) { DUPLOOP(11) { final_phase(F, DRY ? (float*)(ws + WS_A) : F.out); DRYBAR; } }
#undef IN
#undef XN
#undef Y
#undef OX
#undef Z
#undef X1B
#undef XN3
#undef QX
#undef H1
#undef Q
#undef PB
#undef KV
#undef KPE
#undef YG
#undef YMOE
#undef MEMN
#undef KX
#undef VXT
#undef ROPE
#undef SC
#undef ABAR
#undef A256
#undef BBT
#undef CCT
#undef SSQ
#undef SSKV
#undef SSMLA
#undef SSSSM
#undef SSX1
#undef LROW
#undef SEAM
}

#ifndef FASTMASK
#define FASTMASK 0xFFF
#endif
extern "C" void kernel_launch(void* const* d_in, const int* in_sizes, int n_in, void* d_out, int out_size, void* d_ws, size_t ws_size, hipStream_t stream) {
    static int grid = 0;
    if (grid == 0) {
        if (n_in != 37 || in_sizes[0] != T * DM || out_size != T * DM || ws_size < WS_END) { fprintf(stderr, "kernel_launch: unexpected shapes (n_in %d, in0 %d, out %d, ws %zu)\n", n_in, n_in > 0 ? in_sizes[0] : -1, out_size, ws_size); grid = -1; return; }
        int dev = 0, cus = 0, per_cu = 0;
        if (hipGetDevice(&dev) != hipSuccess || hipDeviceGetAttribute(&cus, hipDeviceAttributeMultiprocessorCount, dev) != hipSuccess) { grid = -1; return; }
        if (hipFuncSetAttribute((const void*)mega_fwd, hipFuncAttributeMaxDynamicSharedMemorySize, LDS_BYTES) != hipSuccess) { fprintf(stderr, "kernel_launch: hipFuncSetAttribute failed\n"); grid = -1; return; }
        if (hipOccupancyMaxActiveBlocksPerMultiprocessor(&per_cu, (const void*)mega_fwd, NWAVES * 64, LDS_BYTES) != hipSuccess || per_cu < 1) fprintf(stderr, "kernel_launch: occupancy query says %d\n", per_cu);
        (void)hipGetLastError();
        grid = cus;
    }
    if (grid < 0) return;
    (void)hipMemsetAsync((char*)d_ws + WS_CTL, 0, CTL_ZERO_BYTES, stream);
    Args a{};
    for (int i = 0; i < 37; ++i) a.in[i] = d_in[i];
    a.out = (float*)d_out; a.ws = (unsigned char*)d_ws;
#if DEBUG_HYBRID
    unsigned char* ws = (unsigned char*)d_ws; bf16_t* WT = (bf16_t*)(ws + WS_WT);
    bf16_t* XN = (bf16_t*)(ws + WS_A); bf16_t* Y = XN; bf16_t* OX = XN; bf16_t* Z = (bf16_t*)(ws + WS_Z); bf16_t* X1B = Z;
    bf16_t* QX = (bf16_t*)(ws + WS_QX); bf16_t* Q = (bf16_t*)(ws + WS_Q); bf16_t* KV = (bf16_t*)(ws + WS_KV); bf16_t* KPE = (bf16_t*)(ws + WS_KPE); bf16_t* YG = (bf16_t*)(ws + WS_YG);
    bf16_t* YMOE = (bf16_t*)(ws + WS_YMOE); bf16_t* MEMN = (bf16_t*)(ws + WS_MEMN); bf16_t* KX = (bf16_t*)(ws + WS_KX); bf16_t* VXT = (bf16_t*)(ws + WS_VXT);
    const f32x2* ROPE = (const f32x2*)(ws + WS_ROPE); float* SC = (float*)(ws + WS_SC); unsigned* ctlw = (unsigned*)(ws + WS_CTL);
    ss_t* SSQ = (ss_t*)(ctlw + CW_SSQ); ss_t* SSKV = (ss_t*)(ctlw + CW_SSKV); ss_t* SSMLA = (ss_t*)(ctlw + CW_SSMLA); ss_t* SSSSM = (ss_t*)(ctlw + CW_SSSSM); ss_t* SSX1 = (ss_t*)(ctlw + CW_SSX1);
    const float* const* fin = (const float* const*)d_in; float* out = (float*)d_out;
    for (int s = 0; s < NPHASE; ++s) {
        if (s == 0 || ((FASTMASK >> s) & 1)) { a.ph_lo = s; a.ph_hi = s + 1; hipLaunchKernelGGL(mega_fwd, dim3(grid), dim3(NWAVES * 64), LDS_BYTES, stream, a); continue; }
        switch (s) {
        case 1: hipLaunchKernelGGL(nv::gemm<nv::EZ>, dim3(25, 256), dim3(256), 0, stream, XN, 1024, WT + WT_IN, 1024, 1024, nv::EZ{Z, SSQ, SSKV, KPE, ROPE});
                hipLaunchKernelGGL(nv::gemm<nv::EStore>, dim3(16, 16), dim3(256), 0, stream, MEMN, 1024, WT + WT_XK, 1024, 1024, nv::EStore{KX, 1024});
                hipLaunchKernelGGL(nv::gemm<nv::EVXT>, dim3(16, 16), dim3(256), 0, stream, WT + WT_XV, 1024, MEMN, 1024, 1024, nv::EVXT{VXT}); break;
        case 2: hipLaunchKernelGGL(nv::ssm_a, dim3(2048), dim3(64), 0, stream, Z, ws + WS_TAB, SC);
                hipLaunchKernelGGL(nv::gemm<nv::EQ>, dim3(12, 256), dim3(256), 0, stream, Z + 512, ZP, WT + WT_QUP, 768, 768, nv::EQ{Q, SSQ, ROPE});
                hipLaunchKernelGGL(nv::gemm<nv::EKV>, dim3(16, 256), dim3(256), 0, stream, Z + 1280, ZP, WT + WT_KVUP, 256, 256, nv::EKV{KV, SSKV}); break;
        case 3: hipLaunchKernelGGL(nv::ssm_c, dim3(128), dim3(64), 0, stream, Z, ws + WS_TAB, fin[I_SD], YG);
                hipLaunchKernelGGL(nv::mla_attn, dim3(4 * 8 * 64), dim3(64), 0, stream, Q, KV, KPE, Y, SSMLA); break;
        case 4: hipLaunchKernelGGL(nv::gemm<nv::EGLU>, dim3(8, 256), dim3(256), 0, stream, YG, 512, WT + WT_GLU, 512, 512, nv::EGLU{YG, fin[I_BGLU], Y, SSSSM}); break;
        case 5: hipLaunchKernelGGL(nv::gemm<nv::EOutA>, dim3(16, 256), dim3(256), 0, stream, Y, 1024, WT + WT_OUT, 1024, 512, nv::EOutA{fin[I_X], out, SSSSM});
                hipLaunchKernelGGL(nv::gemm<nv::EOutB>, dim3(16, 256), dim3(256), 0, stream, Y + 512, 1024, WT + WT_OUT + 512, 1024, 512, nv::EOutB{out, X1B, SSMLA, SSX1}); break;
        case 6: hipLaunchKernelGGL(nv::gemm<nv::EXQ>, dim3(16, 256), dim3(256), 0, stream, X1B, 1024, WT + WT_XQ, 1024, 1024, nv::EXQ{QX, SSX1});
                hipLaunchKernelGGL(nv::xattn, dim3(T * 4), dim3(256), 0, stream, QX, KX, VXT, OX); break;
        case 7: hipLaunchKernelGGL(nv::gemm<nv::EAdd>, dim3(16, 256), dim3(256), 0, stream, OX, 1024, WT + WT_XO, 1024, 1024, nv::EAdd{out}); break;
        case 8: hipLaunchKernelGGL(nv::router, dim3(T), dim3(256), 0, stream, out, fin[I_GMOE], fin[I_WGRP], fin[I_BGRP], fin[I_WEXP], fin[I_BEXP], ws); break;
        case 9: hipLaunchKernelGGL(nv::moe_slot, dim3(T * 2), dim3(256), 0, stream, ws); break;
        case 10: break;
        case 11: hipLaunchKernelGGL(nv::final_rows, dim3(T), dim3(256), 0, stream, out, YMOE, fin[I_GFIN]); break;
        }
    }
#else
#ifdef DUP_PHASE
    if (DUP_PHASE > 0) { a.ph_lo = 0; a.ph_hi = DUP_PHASE; a.dry = 0; a.li = 0; hipLaunchKernelGGL(mega_fwd, dim3(grid), dim3(NWAVES * 64), LDS_BYTES, stream, a); }
    a.ph_lo = DUP_PHASE; a.ph_hi = DUP_PHASE + 1; a.dry = 1; a.li = 1; hipLaunchKernelGGL(mega_fwd, dim3(grid), dim3(NWAVES * 64), LDS_BYTES, stream, a);
    a.ph_lo = DUP_PHASE; a.ph_hi = NPHASE; a.dry = 0; a.li = 2; hipLaunchKernelGGL(mega_fwd, dim3(grid), dim3(NWAVES * 64), LDS_BYTES, stream, a);
#else
    a.ph_lo = 0; a.ph_hi = NPHASE;
    hipLaunchKernelGGL(mega_fwd, dim3(grid), dim3(NWAVES * 64), LDS_BYTES, stream, a);
#endif
#endif
    const hipError_t le = hipPeekAtLastError();
    if (le != hipSuccess) fprintf(stderr, "kernel_launch: launch failed: %s\n", hipGetErrorName(le));
}
```

```cpp
#define DEBUG_HYBRID 0
#define FASTMASK 0xFFF

#include <hip/hip_runtime.h>
#include <cstdio>
#include <cstdint>

#define LAS __attribute__((address_space(3)))
#define GAS __attribute__((address_space(1)))
typedef unsigned short bf16_t;
typedef short bf16x8 __attribute__((ext_vector_type(8)));
typedef short s16x4 __attribute__((ext_vector_type(4)));
typedef float f32x2 __attribute__((ext_vector_type(2)));
typedef float f32x4 __attribute__((ext_vector_type(4)));
typedef float f32x8 __attribute__((ext_vector_type(8)));
typedef float f32x16 __attribute__((ext_vector_type(16)));
typedef unsigned u32x2 __attribute__((ext_vector_type(2)));
typedef unsigned u32x4 __attribute__((ext_vector_type(4)));

constexpr int T = 16384, DM = 1024, SEQ = 4096, NBATCH = 4, DIN = 1568, ZP = 1792, NMEM = 256;
constexpr int NEXP = 32, LCAP = 16384;
constexpr float EPS = 1e-6f;
constexpr float LOG2E = 1.4426950408889634f;
constexpr float QS = 0.10206207261596577f * LOG2E;
constexpr float XS = 0.0625f * LOG2E;

constexpr size_t MiB = 1u << 20;
constexpr size_t WS_CTL = 0, CTL_ZERO_BYTES = 1 * MiB;
constexpr size_t WS_ROPE = 1 * MiB;
constexpr size_t WS_MEMN = 3 * MiB;
constexpr size_t WS_KX = 5 * MiB;
constexpr size_t WS_VXT = 7 * MiB;
constexpr size_t WS_SC = 252 * MiB;
constexpr size_t WS_TAB = 10 * MiB;
constexpr size_t TAB_ABAR = 0, TAB_A256 = 16384, TAB_BBT = 65536, TAB_CCT = 262144, TAB_WRH = 524288, TAB_WRL = 524288 + 131072;
constexpr size_t WS_LIST = 11 * MiB;
constexpr size_t WS_LISTD = 13 * MiB;
constexpr size_t WS_LISTW = 15 * MiB;
constexpr size_t WS_TOKI = 17 * MiB;
constexpr size_t WS_WT = 18 * MiB;
constexpr size_t WS_A = 82 * MiB;
constexpr size_t WS_Z = 114 * MiB;
constexpr size_t WS_QX = 146 * MiB;
constexpr size_t WS_Q = 170 * MiB;
constexpr size_t WS_PB = 178 * MiB;
constexpr size_t WS_KV = 194 * MiB;
constexpr size_t WS_KPE = 226 * MiB;
constexpr size_t WS_YG = 227 * MiB;
constexpr size_t WS_YMOE = 166 * MiB;
constexpr size_t WS_END = 256 * MiB;
constexpr size_t WT_IN = 0, WT_QUP = WT_IN + (size_t)ZP * 1024, WT_KVUP = WT_QUP + 768 * 768, WT_GLU = WT_KVUP + 1024 * 256, WT_OUT = WT_GLU + 512 * 512,
                 WT_XQ = WT_OUT + 1024 * 1024, WT_XK = WT_XQ + 1024 * 1024, WT_XV = WT_XK + 1024 * 1024, WT_XO = WT_XV + 1024 * 1024,
                 WT_GU = WT_XO + 1024 * 1024, WT_D = WT_GU + (size_t)32 * 512 * 1024, WT_END = WT_D + (size_t)32 * 1024 * 256;
static_assert(WT_END * 2 <= 64 * MiB, "weights fit");
constexpr int CW_TMO = 0, CW_BAR = 4096  , CW_CNT = 15360, CW_SSQ = 16384, CW_SSKV = CW_SSQ + 2 * T, CW_SSMLA = CW_SSKV + 2 * T, CW_SSSSM = CW_SSMLA + 2 * T, CW_SSX1 = CW_SSSSM + 2 * T;
static_assert((CW_SSX1 + 2 * T) * 4 <= (int)CTL_ZERO_BYTES, "ctl");
typedef unsigned long long ss_t;

__device__ __forceinline__ unsigned f2bf(float f) { unsigned u = __builtin_bit_cast(unsigned, f); return (u + 0x7fffu + ((u >> 16) & 1u)) >> 16; }
__device__ __forceinline__ float bf2f(unsigned short b) { return __builtin_bit_cast(float, (unsigned)b << 16); }
__device__ __forceinline__ unsigned pk2(float lo, float hi) { return f2bf(lo) | (f2bf(hi) << 16); }
__device__ __forceinline__ float bflo(unsigned w) { return __builtin_bit_cast(float, w << 16); }
__device__ __forceinline__ float bfhi(unsigned w) { return __builtin_bit_cast(float, w & 0xffff0000u); }
__device__ __forceinline__ float wave_sum(float v) {
#pragma unroll
    for (int o = 1; o < 64; o <<= 1) v += __shfl_xor(v, o);
    return v;
}
__device__ __forceinline__ float gelu_tanh(float v) {
    const float z = 0.7978845608028654f * (v + 0.044715f * v * v * v);
    const float e = __expf(2.f * z);
    const float th = 1.f - 2.f / (1.f + e);
    return 0.5f * v * (1.f + th);
}
__device__ __forceinline__ void ss_add(ss_t* p, float s) { atomicAdd(p, (ss_t)(s * 16777216.f)); }
__device__ __forceinline__ float ss_get(const ss_t* p) { return (float)(*p) * (1.f / 16777216.f); }
__device__ __forceinline__ float sigmoidf_(float v) { return 1.f / (1.f + __expf(-v)); }

namespace pg8 {
constexpr int BM = 256, BK = 64, HALF = 128, HTB = HALF * BK * 2, STAGE_BYTES = 8 * HTB, NXCD = 8, WGM = 8;
__host__ __device__ __forceinline__ int lds_byte(int r, int c) { const int st = (r >> 4) * 2 + (c >> 5), rr = r & 15, cc = c & 31, ob = rr * 64 + cc * 2; return st * 1024 + (ob ^ (((ob >> 9) & 1) << 5)); }
__host__ __device__ __forceinline__ void stage_rc(int b, int& R, int& C) { const int st = b / 1024, sb = b % 1024, swz = sb ^ (((sb >> 9) & 1) << 5); R = (st >> 1) * 16 + swz / 64; C = (st & 1) * 32 + (swz % 64) / 2; }
__host__ __device__ __forceinline__ int perm32(int rho) { const int n = rho >> 4, i = rho & 15; return 8 * (i >> 2) + 4 * n + (i & 3); }

struct Unit { int pm, pn, aux; };

struct GridOrder {
    int nM, nN, nwg, G, c;
    __device__ __forceinline__ void init(int nM_, int nN_, int G_, int c_) { nM = nM_; nN = nN_; nwg = nM * nN; G = G_; c = c_; }
    __device__ __forceinline__ bool get(int i, int& pm, int& pn) const {
        if (c < 0 || c >= G) return false;
        const long L = (long)i * G + c; if (L >= nwg) return false;
        int wgid = (int)L; { const int q = nwg / NXCD, r = nwg % NXCD, xcd = wgid % NXCD, off = wgid / NXCD; wgid = (xcd < r ? xcd * (q + 1) : r * (q + 1) + (xcd - r) * q) + off; }
        const int nig = WGM * nN, gid = wgid / nig, fm = gid * WGM, gsz = (nM - fm) < WGM ? (nM - fm) : WGM;
        pm = fm + ((wgid % nig) % gsz); pn = (wgid % nig) / gsz; return true;
    }
};

#define PG8_LAS LAS
template <class Epi, class Prob, bool ALIGN_EPI>
__device__ __forceinline__ void gemm_phase(PG8_LAS unsigned char* lds, const Prob& S, const Epi& E) {
    const int tid = threadIdx.x, wid = __builtin_amdgcn_readfirstlane(tid >> 6), lane = tid & 63, wr = wid >> 2, wc = wid & 3, fr = lane & 15, fq = lane >> 4;
    int R[2], C[2]; unsigned vB[2][2];
#pragma unroll
    for (int i = 0; i < 2; ++i) { stage_rc(tid * 16 + i * 8192, R[i], C[i]); const int Rb = Epi::PERM ? ((R[i] & ~31) + perm32(R[i] & 31)) : R[i];
        vB[0][i] = (unsigned)(Rb * S.ldb + C[i]) * 2u; vB[1][i] = (unsigned)((Rb + HALF) * S.ldb + C[i]) * 2u; }
    const size_t kstep = (size_t)(BK * 2);
    const unsigned ldsw = (unsigned)wid * 1024u;
    const int aoff = lds_byte(wr * 64 + fr, fq * 8), boff = lds_byte(wc * 32 + fr, fq * 8);
#define PG8_SA(b, h) (((b) * 2 + (h)) * HTB)
#define PG8_SB(b, h) ((4 + (b) * 2 + (h)) * HTB)
#define PG8_STAGE(bufoff, gbase, voff) do { _Pragma("unroll") for (int _i = 0; _i < 2; ++_i) \
        __builtin_amdgcn_global_load_lds((const unsigned*)((const char*)(gbase) + (voff)[_i]), (PG8_LAS unsigned*)(lds + (bufoff) + ldsw + _i * 8192), 16, 0, 0); } while (0)
#define PG8_LDA(dst, b, h) do { _Pragma("unroll") for (int m = 0; m < 4; ++m) _Pragma("unroll") for (int k = 0; k < 2; ++k) dst[m][k] = *(const PG8_LAS bf16x8*)(lds + PG8_SA(b, h) + aoff + m * 2048 + k * 1024); } while (0)
#define PG8_LDB(dst, b, h) do { _Pragma("unroll") for (int n = 0; n < 2; ++n) _Pragma("unroll") for (int k = 0; k < 2; ++k) dst[n][k] = *(const PG8_LAS bf16x8*)(lds + PG8_SB(b, h) + boff + n * 2048 + k * 1024); } while (0)
#define PG8_MMA(ai, bj, At, Bt) do { __builtin_amdgcn_s_setprio(1); _Pragma("unroll") for (int m = 0; m < 4; ++m) _Pragma("unroll") for (int n = 0; n < 2; ++n) _Pragma("unroll") for (int k = 0; k < 2; ++k) \
        acc[ai][bj][m][n] = __builtin_amdgcn_mfma_f32_16x16x32_bf16(Bt[n][k], At[m][k], acc[ai][bj][m][n], 0, 0, 0); __builtin_amdgcn_s_setprio(0); } while (0)
#define PG8_WAIT_V(n) asm volatile("s_waitcnt vmcnt(" #n ")" ::: "memory")
#define PG8_WAIT_L(n) asm volatile("s_waitcnt lgkmcnt(" #n ")" ::: "memory")
#define PG8_BAR __builtin_amdgcn_s_barrier()
#define PG8_SCHED __builtin_amdgcn_sched_barrier(0)
    Unit cur, nxt; int ui = 0;
    if (!S.next(0, cur)) return;
    unsigned vA[2][2], vAn[2][2];
    S.a_off(cur, R, C, vA);
    f32x4 acc[2][2][4][2];
#pragma unroll
    for (int a = 0; a < 2; ++a)
#pragma unroll
        for (int b = 0; b < 2; ++b)
#pragma unroll
            for (int m = 0; m < 4; ++m)
#pragma unroll
                for (int n = 0; n < 2; ++n) acc[a][b][m][n] = (f32x4){0.f, 0.f, 0.f, 0.f};
    bf16x8 At[4][2], B0[2][2], B1[2][2];
    const char* cA = S.a_ptr(cur); const char* cB = S.b_ptr(cur);
    int nt = S.nkt(cur);
    PG8_STAGE(PG8_SB(0, 0), cB, vB[0]); PG8_STAGE(PG8_SB(0, 1), cB, vB[1]); PG8_STAGE(PG8_SA(0, 0), cA, vA[0]); PG8_STAGE(PG8_SA(0, 1), cA, vA[1]);
    if (wr == 1) PG8_BAR;
    PG8_WAIT_V(2); PG8_BAR;
    PG8_STAGE(PG8_SB(1, 0), cB + kstep, vB[0]); PG8_STAGE(PG8_SA(1, 0), cA + kstep, vA[0]); PG8_STAGE(PG8_SB(1, 1), cB + kstep, vB[1]);
    PG8_WAIT_V(6); PG8_BAR;
    for (;;) {
        const bool has_next = S.next(ui + 1, nxt);
        const char* nA = has_next ? S.a_ptr(nxt) : cA; const char* nB = has_next ? S.b_ptr(nxt) : cB;
        if constexpr (Prob::GATHER) { if (has_next) S.a_off(nxt, R, C, vAn); else { vAn[0][0] = vA[0][0]; vAn[0][1] = vA[0][1]; vAn[1][0] = vA[1][0]; vAn[1][1] = vA[1][1]; } }
        for (int t = 0; t < nt; t += 2) {
            const bool last = (t == nt - 2);
            if constexpr (Epi::MIDK) { if (t == (nt >> 1)) { int fr3 = fr, fq3 = fq; asm volatile("" : "+v"(fr3), "+v"(fq3)); E.mid(acc, cur, wr, wc, fr3, fq3); } }
            const char* a1 = cA + (size_t)(t + 1) * kstep;
            const char* a2 = last ? nA : cA + (size_t)(t + 2) * kstep; const char* b2 = last ? nB : cB + (size_t)(t + 2) * kstep;
            const char* a3 = a2 + kstep; const char* b3 = b2 + kstep;
            unsigned w0[2], w1[2];
            if constexpr (Prob::GATHER) { w0[0] = last ? vAn[0][0] : vA[0][0]; w0[1] = last ? vAn[0][1] : vA[0][1]; w1[0] = last ? vAn[1][0] : vA[1][0]; w1[1] = last ? vAn[1][1] : vA[1][1]; }
            else { w0[0] = vA[0][0]; w0[1] = vA[0][1]; w1[0] = vA[1][0]; w1[1] = vA[1][1]; }
            PG8_LDB(B0, 0, 0); PG8_LDB(B1, 0, 1); PG8_SCHED; PG8_LDA(At, 0, 0); PG8_STAGE(PG8_SA(1, 1), a1, vA[1]);
            PG8_WAIT_V(8); PG8_WAIT_L(0); PG8_BAR; PG8_MMA(0, 0, At, B0); PG8_MMA(0, 1, At, B1); PG8_BAR; PG8_SCHED;
            PG8_LDA(At, 0, 1); PG8_STAGE(PG8_SB(0, 0), b2, vB[0]); PG8_STAGE(PG8_SB(0, 1), b2, vB[1]); PG8_STAGE(PG8_SA(0, 0), a2, w0);
            PG8_WAIT_V(8); PG8_WAIT_L(0); PG8_BAR; PG8_MMA(1, 0, At, B0); PG8_MMA(1, 1, At, B1); PG8_BAR; PG8_SCHED;
            PG8_LDB(B0, 1, 0); PG8_LDB(B1, 1, 1); PG8_SCHED; PG8_LDA(At, 1, 0); PG8_STAGE(PG8_SA(0, 1), a2, w1);
            PG8_WAIT_V(8); PG8_WAIT_L(0); PG8_BAR; PG8_MMA(0, 0, At, B0); PG8_MMA(0, 1, At, B1); PG8_BAR; PG8_SCHED;
            PG8_LDA(At, 1, 1); PG8_STAGE(PG8_SB(1, 0), b3, vB[0]); PG8_STAGE(PG8_SB(1, 1), b3, vB[1]); PG8_STAGE(PG8_SA(1, 0), a3, w0);
            PG8_WAIT_V(8); PG8_WAIT_L(0); PG8_BAR; PG8_MMA(1, 0, At, B0); PG8_MMA(1, 1, At, B1); PG8_BAR; PG8_SCHED;
        }
        if constexpr (ALIGN_EPI) { if (wr == 0) PG8_BAR; }
        if constexpr (!Epi::AFTER_DRAIN) { int fr2 = fr, fq2 = fq; asm volatile("" : "+v"(fr2), "+v"(fq2)); E(acc, cur, wr, wc, fr2, fq2); }
        if (!has_next) break;
#pragma unroll
        for (int a = 0; a < 2; ++a)
#pragma unroll
            for (int b = 0; b < 2; ++b)
#pragma unroll
                for (int m = 0; m < 4; ++m)
#pragma unroll
                    for (int n = 0; n < 2; ++n) acc[a][b][m][n] = (f32x4){0.f, 0.f, 0.f, 0.f};
        cur = nxt; cA = nA; cB = nB; ++ui; nt = S.nkt(cur);
        if constexpr (Prob::GATHER) { vA[0][0] = vAn[0][0]; vA[0][1] = vAn[0][1]; vA[1][0] = vAn[1][0]; vA[1][1] = vAn[1][1]; }
        if constexpr (ALIGN_EPI) { if (wr == 1) PG8_BAR; }
    }
    PG8_WAIT_V(0);
    if constexpr (!ALIGN_EPI) { if (wr == 0) PG8_BAR; }
    PG8_BAR;
    if constexpr (Epi::AFTER_DRAIN) { int fr2 = fr, fq2 = fq; asm volatile("" : "+v"(fr2), "+v"(fq2)); E.fused(acc, cur, wr, wc, fr2, fq2, lds, wid, lane); }
#undef PG8_SA
#undef PG8_SB
#undef PG8_STAGE
#undef PG8_LDA
#undef PG8_LDB
#undef PG8_MMA
#undef PG8_WAIT_V
#undef PG8_WAIT_L
#undef PG8_BAR
#undef PG8_SCHED
}

struct ProbDense {
    static constexpr bool GATHER = false;
    const bf16_t* A; const bf16_t* Bt; int lda, ldb, K; GridOrder O;
    __device__ __forceinline__ bool next(int i, Unit& u) const { u.aux = 0; return O.get(i, u.pm, u.pn); }
    __device__ __forceinline__ int nkt(const Unit&) const { return K / BK; }
    __device__ __forceinline__ const char* a_ptr(const Unit& u) const { return (const char*)(A + (size_t)u.pm * BM * lda); }
    __device__ __forceinline__ const char* b_ptr(const Unit& u) const { return (const char*)(Bt + (size_t)u.pn * BM * ldb); }
    __device__ __forceinline__ void a_off(const Unit&, const int (&R)[2], const int (&C)[2], unsigned (&v)[2][2]) const {
#pragma unroll
        for (int i = 0; i < 2; ++i) { v[0][i] = (unsigned)(R[i] * lda + C[i]) * 2u; v[1][i] = (unsigned)((R[i] + HALF) * lda + C[i]) * 2u; }
    }
};
struct ProbOne {
    static constexpr bool GATHER = false;
    const bf16_t* A; const bf16_t* Bt; int lda, ldb, K, pm, pn;
    __device__ __forceinline__ bool next(int i, Unit& u) const { u.pm = pm; u.pn = pn; u.aux = 0; return i == 0; }
    __device__ __forceinline__ int nkt(const Unit&) const { return K / BK; }
    __device__ __forceinline__ const char* a_ptr(const Unit&) const { return (const char*)A; }
    __device__ __forceinline__ const char* b_ptr(const Unit&) const { return (const char*)Bt; }
    __device__ __forceinline__ void a_off(const Unit&, const int (&R)[2], const int (&C)[2], unsigned (&v)[2][2]) const {
#pragma unroll
        for (int i = 0; i < 2; ++i) { v[0][i] = (unsigned)(R[i] * lda + C[i]) * 2u; v[1][i] = (unsigned)((R[i] + HALF) * lda + C[i]) * 2u; }
    }
};
}

namespace epi {
using pg8::Unit;
typedef f32x4 Acc[2][2][4][2];
__device__ __forceinline__ u32x4 pack8(const f32x4 a, const f32x4 b) { u32x4 w; w.x = pk2(a[0], a[1]); w.y = pk2(a[2], a[3]); w.z = pk2(b[0], b[1]); w.w = pk2(b[2], b[3]); return w; }
__device__ __forceinline__ float sq4(const f32x4 a) { return (a[0] * a[0] + a[1] * a[1]) + (a[2] * a[2] + a[3] * a[3]); }
__device__ __forceinline__ void rope8(f32x4& v0, f32x4& v1, const f32x2* rp  , int fq) {
    float o[8], v[8] = {v0[0], v0[1], v0[2], v0[3], v1[0], v1[1], v1[2], v1[3]};
#pragma unroll
    for (int j = 0; j < 8; ++j) o[j] = __shfl_xor(v[j], 32);
    const int i0 = 8 * (fq & 1);
#pragma unroll
    for (int j = 0; j < 8; ++j) { const f32x2 cs = rp[i0 + j]; v[j] = (fq < 2) ? (v[j] * cs.x - o[j] * cs.y) : (o[j] * cs.y + v[j] * cs.x); }
    v0 = (f32x4){v[0], v[1], v[2], v[3]}; v1 = (f32x4){v[4], v[5], v[6], v[7]};
}

struct EpiZ {
    static constexpr bool PERM = true, AFTER_DRAIN = false, MIDK = false;
    bf16_t* z; ss_t* ssq; ss_t* sskv; bf16_t* kpe; const f32x2* rope;
    __device__ __forceinline__ void operator()(const Acc& acc, const Unit& u, int wr, int wc, int fr, int fq) const {
        const int pn = u.pn;
        if (pn < 6) {
#pragma unroll
            for (int ai = 0; ai < 2; ++ai)
#pragma unroll
                for (int m = 0; m < 4; ++m) { const int row = u.pm * 256 + ai * 128 + wr * 64 + m * 16 + fr; float s = 0.f;
#pragma unroll
                    for (int bj = 0; bj < 2; ++bj) { const int col = pn * 256 + bj * 128 + wc * 32 + 8 * fq;
                        *(u32x4*)(z + (size_t)row * ZP + col) = pack8(acc[ai][bj][m][0], acc[ai][bj][m][1]); s += sq4(acc[ai][bj][m][0]) + sq4(acc[ai][bj][m][1]); }
                    if (pn >= 2) { s += __shfl_xor(s, 16); s += __shfl_xor(s, 32); if (fq == 0) ss_add((pn < 5 ? ssq : sskv) + row, s); } }
        } else if (wc == 0) {
#pragma unroll
            for (int ai = 0; ai < 2; ++ai)
#pragma unroll
                for (int m = 0; m < 4; ++m) { const int row = u.pm * 256 + ai * 128 + wr * 64 + m * 16 + fr;
                    f32x4 v0 = acc[ai][0][m][0], v1 = acc[ai][0][m][1]; rope8(v0, v1, rope + (size_t)row * 16, fq);
                    *(u32x4*)(kpe + (size_t)row * 32 + 8 * fq) = pack8(v0, v1); }
        }
    }
};
struct EpiStore {
    static constexpr bool PERM = true, AFTER_DRAIN = false, MIDK = false;
    bf16_t* O; int ldc;
    __device__ __forceinline__ void operator()(const Acc& acc, const Unit& u, int wr, int wc, int fr, int fq) const {
#pragma unroll
        for (int ai = 0; ai < 2; ++ai)
#pragma unroll
            for (int m = 0; m < 4; ++m) { const int row = u.pm * 256 + ai * 128 + wr * 64 + m * 16 + fr;
#pragma unroll
                for (int bj = 0; bj < 2; ++bj) { const int col = u.pn * 256 + bj * 128 + wc * 32 + 8 * fq;
                    *(u32x4*)(O + (size_t)row * ldc + col) = pack8(acc[ai][bj][m][0], acc[ai][bj][m][1]); } }
    }
};
struct EpiVXT {
    static constexpr bool PERM = true, AFTER_DRAIN = false, MIDK = false;
    bf16_t* O;
    __device__ __forceinline__ void operator()(const Acc& acc, const Unit& u, int wr, int wc, int fr, int fq) const {
#pragma unroll
        for (int ai = 0; ai < 2; ++ai)
#pragma unroll
            for (int m = 0; m < 4; ++m) { const int row = u.pm * 256 + ai * 128 + wr * 64 + m * 16 + fr;
#pragma unroll
                for (int bj = 0; bj < 2; ++bj) { const int key = bj * 128 + wc * 32 + 8 * fq;
                    *(u32x4*)(O + (size_t)u.pn * 262144 + (size_t)row * 256 + key) = pack8(acc[ai][bj][m][0], acc[ai][bj][m][1]); } }
    }
};
struct EpiQ {
    static constexpr bool PERM = true, AFTER_DRAIN = false, MIDK = false;
    bf16_t* q; const ss_t* ssq; const f32x2* rope;
    __device__ __forceinline__ void operator()(const Acc& acc, const Unit& u, int wr, int wc, int fr, int fq) const {
#pragma unroll
        for (int ai = 0; ai < 2; ++ai)
#pragma unroll
            for (int m = 0; m < 4; ++m) { const int row = u.pm * 256 + ai * 128 + wr * 64 + m * 16 + fr;
                const float rs = __builtin_amdgcn_rsqf(ss_get(ssq + row) * (1.f / 768.f) + EPS) * QS;
#pragma unroll
                for (int bj = 0; bj < 2; ++bj) { const int g32 = u.pn * 8 + bj * 4 + wc, col = g32 * 32 + 8 * fq;
                    f32x4 v0 = acc[ai][bj][m][0] * rs, v1 = acc[ai][bj][m][1] * rs;
                    if (g32 % 3 == 2) rope8(v0, v1, rope + (size_t)row * 16, fq);
                    *(u32x4*)(q + (size_t)row * 768 + col) = pack8(v0, v1); } }
    }
};
struct EpiKV {
    static constexpr bool PERM = true, AFTER_DRAIN = false, MIDK = false;
    bf16_t* kv; const ss_t* sskv;
    __device__ __forceinline__ void operator()(const Acc& acc, const Unit& u, int wr, int wc, int fr, int fq) const {
#pragma unroll
        for (int ai = 0; ai < 2; ++ai)
#pragma unroll
            for (int m = 0; m < 4; ++m) { const int row = u.pm * 256 + ai * 128 + wr * 64 + m * 16 + fr;
                const float rs = __builtin_amdgcn_rsqf(ss_get(sskv + row) * (1.f / 256.f) + EPS);
#pragma unroll
                for (int bj = 0; bj < 2; ++bj) { const int col = u.pn * 256 + bj * 128 + wc * 32 + 8 * fq;
                    *(u32x4*)(kv + (size_t)row * 1024 + col) = pack8(acc[ai][bj][m][0] * rs, acc[ai][bj][m][1] * rs); } }
    }
};
struct EpiGLU {
    static constexpr bool PERM = true, AFTER_DRAIN = false, MIDK = false;
    const bf16_t* yg; const float* bias; bf16_t* y; ss_t* ss;
    __device__ __forceinline__ void operator()(const Acc& acc, const Unit& u, int wr, int wc, int fr, int fq) const {
#pragma unroll
        for (int ai = 0; ai < 2; ++ai)
#pragma unroll
            for (int m = 0; m < 4; ++m) { const int row = u.pm * 256 + ai * 128 + wr * 64 + m * 16 + fr; float s = 0.f;
#pragma unroll
                for (int bj = 0; bj < 2; ++bj) { const int col = u.pn * 256 + bj * 128 + wc * 32 + 8 * fq;
                    const u32x4 g = *(const u32x4*)(yg + (size_t)row * 512 + col);
                    const f32x4 b0 = *(const f32x4*)(bias + col), b1 = *(const f32x4*)(bias + col + 4);
                    const f32x4 a0 = acc[ai][bj][m][0] + b0, a1 = acc[ai][bj][m][1] + b1;
                    f32x4 o0, o1;
                    o0[0] = bflo(g.x) * sigmoidf_(a0[0]); o0[1] = bfhi(g.x) * sigmoidf_(a0[1]); o0[2] = bflo(g.y) * sigmoidf_(a0[2]); o0[3] = bfhi(g.y) * sigmoidf_(a0[3]);
                    o1[0] = bflo(g.z) * sigmoidf_(a1[0]); o1[1] = bfhi(g.z) * sigmoidf_(a1[1]); o1[2] = bflo(g.w) * sigmoidf_(a1[2]); o1[3] = bfhi(g.w) * sigmoidf_(a1[3]);
                    s += sq4(o0) + sq4(o1);
                    *(u32x4*)(y + (size_t)row * 1024 + col) = pack8(o0, o1); }
                s += __shfl_xor(s, 16); s += __shfl_xor(s, 32); if (fq == 0) ss_add(ss + row, s); }
    }
};
struct EpiOutA {
    static constexpr bool PERM = false, AFTER_DRAIN = false, MIDK = false;
    const float* base; float* out; const ss_t* ss;
    __device__ __forceinline__ void operator()(const Acc& acc, const Unit& u, int wr, int wc, int fr, int fq) const {
#pragma unroll
        for (int ai = 0; ai < 2; ++ai)
#pragma unroll
            for (int m = 0; m < 4; ++m) { const int row = u.pm * 256 + ai * 128 + wr * 64 + m * 16 + fr;
                const float rs = __builtin_amdgcn_rsqf(ss_get(ss + row) * (1.f / 512.f) + EPS);
#pragma unroll
                for (int bj = 0; bj < 2; ++bj)
#pragma unroll
                    for (int n = 0; n < 2; ++n) { const size_t off = (size_t)row * 1024 + u.pn * 256 + bj * 128 + wc * 32 + 16 * n + 4 * fq;
                        *(f32x4*)(out + off) = *(const f32x4*)(base + off) + acc[ai][bj][m][n] * rs; } }
    }
};
struct EpiOutB {
    static constexpr bool PERM = false, AFTER_DRAIN = false, MIDK = false;
    float* out; bf16_t* xb; const ss_t* ss; ss_t* ssx;
    __device__ __forceinline__ void operator()(const Acc& acc, const Unit& u, int wr, int wc, int fr, int fq) const {
#pragma unroll
        for (int ai = 0; ai < 2; ++ai)
#pragma unroll
            for (int m = 0; m < 4; ++m) { const int row = u.pm * 256 + ai * 128 + wr * 64 + m * 16 + fr; float s = 0.f;
                const float rs = __builtin_amdgcn_rsqf(ss_get(ss + row) * (1.f / 512.f) + EPS);
#pragma unroll
                for (int bj = 0; bj < 2; ++bj)
#pragma unroll
                    for (int n = 0; n < 2; ++n) { const size_t off = (size_t)row * 1024 + u.pn * 256 + bj * 128 + wc * 32 + 16 * n + 4 * fq;
                        const f32x4 x1 = *(const f32x4*)(out + off) + acc[ai][bj][m][n] * rs; s += sq4(x1);
                        *(f32x4*)(out + off) = x1; u32x2 w; w.x = pk2(x1[0], x1[1]); w.y = pk2(x1[2], x1[3]); *(u32x2*)(xb + off) = w; }
                s += __shfl_xor(s, 16); s += __shfl_xor(s, 32); if (fq == 0) ss_add(ssx + row, s); }
    }
};
struct EpiOut {
    static constexpr bool PERM = false, AFTER_DRAIN = false, MIDK = true;
    const float* base; float* out; bf16_t* xb; const ss_t* ss1; const ss_t* ss2; ss_t* ssx;
    __device__ __forceinline__ void mid(Acc& acc, const Unit& u, int wr, int wc, int fr, int fq) const {
#pragma unroll
        for (int ai = 0; ai < 2; ++ai)
#pragma unroll
            for (int m = 0; m < 4; ++m) { const int row = u.pm * 256 + ai * 128 + wr * 64 + m * 16 + fr;
                const float r1 = __builtin_amdgcn_rsqf(ss_get(ss1 + row) * (1.f / 512.f) + EPS), r2 = __builtin_amdgcn_rsqf(ss_get(ss2 + row) * (1.f / 512.f) + EPS); const float f = r1 / r2;
#pragma unroll
                for (int bj = 0; bj < 2; ++bj)
#pragma unroll
                    for (int n = 0; n < 2; ++n) acc[ai][bj][m][n] = acc[ai][bj][m][n] * f;
                asm volatile("" ::: "memory"); }
    }
    __device__ __forceinline__ void operator()(const Acc& acc, const Unit& u, int wr, int wc, int fr, int fq) const {
#pragma unroll
        for (int ai = 0; ai < 2; ++ai)
#pragma unroll
            for (int m = 0; m < 4; ++m) { const int row = u.pm * 256 + ai * 128 + wr * 64 + m * 16 + fr; float s = 0.f;
                const float rs = __builtin_amdgcn_rsqf(ss_get(ss2 + row) * (1.f / 512.f) + EPS);
#pragma unroll
                for (int bj = 0; bj < 2; ++bj)
#pragma unroll
                    for (int n = 0; n < 2; ++n) { const size_t off = (size_t)row * 1024 + u.pn * 256 + bj * 128 + wc * 32 + 16 * n + 4 * fq;
                        const f32x4 x1 = *(const f32x4*)(base + off) + acc[ai][bj][m][n] * rs; s += sq4(x1);
                        *(f32x4*)(out + off) = x1; u32x2 w; w.x = pk2(x1[0], x1[1]); w.y = pk2(x1[2], x1[3]); *(u32x2*)(xb + off) = w; }
                s += __shfl_xor(s, 16); s += __shfl_xor(s, 32); if (fq == 0) ss_add(ssx + row, s); }
    }
};
struct EpiXQ {
    static constexpr bool PERM = true, AFTER_DRAIN = false, MIDK = false;
    bf16_t* O; const ss_t* ss;
    __device__ __forceinline__ void operator()(const Acc& acc, const Unit& u, int wr, int wc, int fr, int fq) const {
#pragma unroll
        for (int ai = 0; ai < 2; ++ai)
#pragma unroll
            for (int m = 0; m < 4; ++m) { const int row = u.pm * 256 + ai * 128 + wr * 64 + m * 16 + fr;
                const float rs = __builtin_amdgcn_rsqf(ss_get(ss + row) * (1.f / 1024.f) + EPS) * XS;
#pragma unroll
                for (int bj = 0; bj < 2; ++bj) { const int col = u.pn * 256 + bj * 128 + wc * 32 + 8 * fq;
                    *(u32x4*)(O + (size_t)row * 1024 + col) = pack8(acc[ai][bj][m][0] * rs, acc[ai][bj][m][1] * rs); } }
    }
};
struct EpiSoft {
    static constexpr bool PERM = true, AFTER_DRAIN = true, MIDK = false;
    bf16_t* P; float* lrow;
    __device__ __forceinline__ void fused(Acc& acc, const Unit& u, int wr, int wc, int fr, int fq, LAS unsigned char* lds, int wid, int lane) const {
        LAS float* M1 = (LAS float*)lds;
        LAS float* M2 = (LAS float*)(lds + 4096);
#pragma unroll
        for (int ai = 0; ai < 2; ++ai)
#pragma unroll
            for (int m = 0; m < 4; ++m) { float mx = -3.0e38f;
#pragma unroll
                for (int bj = 0; bj < 2; ++bj)
#pragma unroll
                    for (int n = 0; n < 2; ++n) { const f32x4 x = acc[ai][bj][m][n]; mx = fmaxf(mx, fmaxf(fmaxf(x[0], x[1]), fmaxf(x[2], x[3]))); }
                mx = fmaxf(mx, __shfl_xor(mx, 16)); mx = fmaxf(mx, __shfl_xor(mx, 32));
                if (fq == 0) M1[(ai * 128 + wr * 64 + m * 16 + fr) * 4 + wc] = mx; }
        asm volatile("s_waitcnt lgkmcnt(0)" ::: "memory"); __builtin_amdgcn_s_barrier(); asm volatile("" ::: "memory");
#pragma unroll
        for (int ai = 0; ai < 2; ++ai)
#pragma unroll
            for (int m = 0; m < 4; ++m) { const int r = ai * 128 + wr * 64 + m * 16 + fr; const int row = u.pm * 256 + r;
                const f32x4 mm = *(const LAS f32x4*)(M1 + r * 4); const float mx = fmaxf(fmaxf(mm[0], mm[1]), fmaxf(mm[2], mm[3])); float s = 0.f;
#pragma unroll
                for (int bj = 0; bj < 2; ++bj) { f32x4 p0, p1;
#pragma unroll
                    for (int e = 0; e < 4; ++e) { p0[e] = __builtin_amdgcn_exp2f(acc[ai][bj][m][0][e] - mx); p1[e] = __builtin_amdgcn_exp2f(acc[ai][bj][m][1][e] - mx); }
                    s += (p0[0] + p0[1]) + (p0[2] + p0[3]) + (p1[0] + p1[1]) + (p1[2] + p1[3]);
                    const int col = u.pn * 256 + bj * 128 + wc * 32 + 8 * fq;
                    *(u32x4*)(P + (size_t)row * 1024 + col) = pack8(p0, p1); }
                s += __shfl_xor(s, 16); s += __shfl_xor(s, 32);
                if (fq == 0) M2[r * 4 + wc] = s; }
        asm volatile("s_waitcnt lgkmcnt(0)" ::: "memory"); __builtin_amdgcn_s_barrier(); asm volatile("" ::: "memory");
        if (wid < 4) { const int r = wid * 64 + lane; const f32x4 ss = *(const LAS f32x4*)(M2 + r * 4);
            __hip_atomic_store(lrow + (size_t)(u.pm * 256 + r) * 4 + u.pn, (ss[0] + ss[1]) + (ss[2] + ss[3]), __ATOMIC_RELAXED, __HIP_MEMORY_SCOPE_AGENT); }
    }
};
struct EpiPV {
    static constexpr bool PERM = true, AFTER_DRAIN = false, MIDK = false;
    bf16_t* O; const float* lrow;
    __device__ __forceinline__ void operator()(const Acc& acc, const Unit& u, int wr, int wc, int fr, int fq) const {
#pragma unroll
        for (int ai = 0; ai < 2; ++ai)
#pragma unroll
            for (int m = 0; m < 4; ++m) { const int row = u.pm * 256 + ai * 128 + wr * 64 + m * 16 + fr;
                const float rl = 1.f / __hip_atomic_load(lrow + (size_t)row * 4 + u.pn, __ATOMIC_RELAXED, __HIP_MEMORY_SCOPE_AGENT);
#pragma unroll
                for (int bj = 0; bj < 2; ++bj) { const int col = u.pn * 256 + bj * 128 + wc * 32 + 8 * fq;
                    *(u32x4*)(O + (size_t)row * 1024 + col) = pack8(acc[ai][bj][m][0] * rl, acc[ai][bj][m][1] * rl); } }
    }
};
struct EpiAdd {
    static constexpr bool PERM = false, AFTER_DRAIN = false, MIDK = false;
    const float* in; float* out;
    __device__ __forceinline__ void operator()(const Acc& acc, const Unit& u, int wr, int wc, int fr, int fq) const {
#pragma unroll
        for (int ai = 0; ai < 2; ++ai)
#pragma unroll
            for (int m = 0; m < 4; ++m) { const int row = u.pm * 256 + ai * 128 + wr * 64 + m * 16 + fr;
#pragma unroll
                for (int bj = 0; bj < 2; ++bj)
#pragma unroll
                    for (int n = 0; n < 2; ++n) { const size_t off = (size_t)row * 1024 + u.pn * 256 + bj * 128 + wc * 32 + 16 * n + 4 * fq;
                        *(f32x4*)(out + off) = *(const f32x4*)(in + off) + acc[ai][bj][m][n]; } }
    }
};
}

namespace mla {
constexpr int NW = 8, QBLK = 32, KVBLK = 64;
constexpr int SHM_V = KVBLK * 64 * 2, SHM_K = KVBLK * 256;
constexpr int LDS_V = 0, LDS_K = 2 * SHM_V, LDS_WS = LDS_K + 2 * SHM_K, LDS_BYTES = LDS_WS + NW * 64 * 4;
constexpr float THR = 8.f;
#define KSWZ(row, colB) ((row) * 256 + ((colB) ^ (((row) & 7) << 4)))
#define SBAR() __builtin_amdgcn_sched_barrier(0)
__device__ __forceinline__ int crow(int r, int hi) { return (r & 3) + 8 * (r >> 2) + 4 * hi; }
__device__ __forceinline__ unsigned cvtpk(float lo, float hi) { unsigned r; asm volatile("v_cvt_pk_bf16_f32 %0, %1, %2" : "=v"(r) : "v"(lo), "v"(hi)); return r; }
__device__ __forceinline__ void partialSM(f32x16& p0, f32x16& p1, float& m_reg, float& mn, float& alpha) {
    float pmax = p0[0];
#pragma unroll
    for (int r = 1; r < 16; ++r) pmax = fmaxf(pmax, p0[r]);
#pragma unroll
    for (int r = 0; r < 16; ++r) pmax = fmaxf(pmax, p1[r]);
    { auto rr = __builtin_amdgcn_permlane32_swap(__float_as_uint(pmax), __float_as_uint(pmax), false, false); pmax = fmaxf(__uint_as_float(rr[0]), __uint_as_float(rr[1])); }
    if (__builtin_expect(__all(pmax - m_reg <= THR), 1)) { mn = m_reg; alpha = 1.f; }
    else { mn = fmaxf(m_reg, pmax); alpha = __builtin_amdgcn_exp2f(m_reg - mn); m_reg = mn; }
#pragma unroll
    for (int r = 0; r < 16; ++r) p0[r] = p0[r] - mn;
#pragma unroll
    for (int r = 0; r < 16; ++r) p1[r] = p1[r] - mn;
#pragma unroll
    for (int r = 0; r < 16; ++r) p0[r] = __builtin_amdgcn_exp2f(p0[r]);
}
__device__ __forceinline__ void finishSM(f32x16& p0, f32x16& p1, float alpha, float& l_reg, bf16x8& pa0, bf16x8& pa1, bf16x8& pa2, bf16x8& pa3) {
#pragma unroll
    for (int r = 0; r < 16; ++r) p1[r] = __builtin_amdgcn_exp2f(p1[r]);
    float ps = 0;
#pragma unroll
    for (int r = 0; r < 16; ++r) ps += p0[r];
#pragma unroll
    for (int r = 0; r < 16; ++r) ps += p1[r];
    { auto rr = __builtin_amdgcn_permlane32_swap(__float_as_uint(ps), __float_as_uint(ps), false, false); ps = __uint_as_float(rr[0]) + __uint_as_float(rr[1]); }
    l_reg = l_reg * alpha + ps;
#define PK4(P, BASE, OUT) do { unsigned a0 = cvtpk(P[BASE + 0], P[BASE + 1]), a1 = cvtpk(P[BASE + 2], P[BASE + 3]);   \
    unsigned b0 = cvtpk(P[BASE + 4], P[BASE + 5]), b1 = cvtpk(P[BASE + 6], P[BASE + 7]);                              \
    auto r0 = __builtin_amdgcn_permlane32_swap(a0, b0, false, false); auto r1 = __builtin_amdgcn_permlane32_swap(a1, b1, false, false); \
    u32x4 w = {r0[0], r1[0], r0[1], r1[1]}; OUT = *reinterpret_cast<bf16x8*>(&w); } while (0)
    PK4(p0, 0, pa0); PK4(p0, 8, pa1); PK4(p1, 0, pa2); PK4(p1, 8, pa3);
#undef PK4
}
__device__ __forceinline__ void qkt(f32x16& p0, f32x16& p1, const char* Ks, const bf16x8* qr, int r32, int hi, bool masked) {
    p0 = f32x16{}; p1 = f32x16{};
#pragma unroll
    for (int d0 = 0; d0 < 6; ++d0) { const int cb = (d0 * 16 + hi * 8) * 2;
        const bf16x8 b0 = *reinterpret_cast<const bf16x8*>(Ks + KSWZ(r32, cb));
        const bf16x8 b1 = *reinterpret_cast<const bf16x8*>(Ks + KSWZ(32 + r32, cb));
        p0 = __builtin_amdgcn_mfma_f32_32x32x16_bf16(b0, qr[d0], p0, 0, 0, 0);
        p1 = __builtin_amdgcn_mfma_f32_32x32x16_bf16(b1, qr[d0], p1, 0, 0, 0); }
    if (masked) {
#pragma unroll
        for (int r = 0; r < 16; ++r) { p0[r] = -INFINITY; p1[r] = -INFINITY; } }
}
__device__ __forceinline__ int v_st(int k, int c) { const int kk = (k & ~0xC) | ((k & 4) << 1) | ((k & 8) >> 1); return ((kk >> 3) * 2 + (c >> 5)) * 512 + ((kk & 7) * 32 + (c & 31)) * 2; }
__device__ __forceinline__ int v_rd_base(int lane) { return ((lane & 3) << 3) | (((lane >> 2) & 3) << 6) | (((lane >> 4) & 1) << 5) | (((lane >> 5) & 1) << 8); }
constexpr int v_rd_off(int d0, int ks, int half) { return d0 * 512 + ks * 2048 + half * 1024; }
template <int OFF> __device__ __forceinline__ s16x4 tr_read(int vb) { s16x4 r; asm volatile("ds_read_b64_tr_b16 %0, %1 offset:%2" : "=&v"(r) : "v"(vb), "i"(OFF) : "memory"); return r; }
template <int D0> __device__ __forceinline__ void pv_one(f32x16& od, int vb, bf16x8 pa0, bf16x8 pa1, bf16x8 pa2, bf16x8 pa3) {
    const s16x4 l0 = tr_read<v_rd_off(D0, 0, 0)>(vb), h0 = tr_read<v_rd_off(D0, 0, 1)>(vb), l1 = tr_read<v_rd_off(D0, 1, 0)>(vb), h1 = tr_read<v_rd_off(D0, 1, 1)>(vb);
    const s16x4 l2 = tr_read<v_rd_off(D0, 2, 0)>(vb), h2 = tr_read<v_rd_off(D0, 2, 1)>(vb), l3 = tr_read<v_rd_off(D0, 3, 0)>(vb), h3 = tr_read<v_rd_off(D0, 3, 1)>(vb);
    asm volatile("s_waitcnt lgkmcnt(0)" ::: "memory"); SBAR();
#define PK(L, H) (bf16x8){L[0], L[1], L[2], L[3], H[0], H[1], H[2], H[3]}
    od = __builtin_amdgcn_mfma_f32_32x32x16_bf16(pa0, PK(l0, h0), od, 0, 0, 0);
    od = __builtin_amdgcn_mfma_f32_32x32x16_bf16(pa1, PK(l1, h1), od, 0, 0, 0);
    od = __builtin_amdgcn_mfma_f32_32x32x16_bf16(pa2, PK(l2, h2), od, 0, 0, 0);
    od = __builtin_amdgcn_mfma_f32_32x32x16_bf16(pa3, PK(l3, h3), od, 0, 0, 0);
#undef PK
}
__device__ __forceinline__ void pv_d0(f32x16* o, int vb, bf16x8 pa0, bf16x8 pa1, bf16x8 pa2, bf16x8 pa3) { pv_one<0>(o[0], vb, pa0, pa1, pa2, pa3); pv_one<1>(o[1], vb, pa0, pa1, pa2, pa3); }

__device__ __forceinline__ void unit(int b, int h, int qb, const bf16_t* __restrict__ q, const bf16_t* __restrict__ kv, const bf16_t* __restrict__ kpe, bf16_t* y, ss_t* ssm, char* lds) {
    const int tid = threadIdx.x, wid = tid >> 6, lane = tid & 63, r32 = lane & 31, hi = lane >> 5;
    char* V_lds = lds + LDS_V; char* K_lds = lds + LDS_K;
    float* ws = (float*)(lds + LDS_WS) + wid * 64; float* li_l = ws; float* al_l = ws + 32;
    float m_reg = -1e30f, l_reg = 0; f32x16 o[2] = {}; bf16x8 qr[6];
    const size_t row0 = (size_t)b * SEQ + (size_t)qb * 256, krow0 = (size_t)b * SEQ;
    const bf16_t* Qw = q + (row0 + wid * QBLK + r32) * 768 + h * 96 + hi * 8;
#pragma unroll
    for (int d0 = 0; d0 < 6; ++d0) qr[d0] = *reinterpret_cast<const bf16x8*>(Qw + d0 * 16);
    const int skey = tid >> 3, sc = (tid & 7) * 8, pkey = (tid & 255) >> 2, pc = (tid & 3) * 8;
    const int vst = v_st(skey, sc), kst = KSWZ(skey, sc * 2), pst = KSWZ(pkey, (64 + pc) * 2);
    const int vb0 = (int)(uintptr_t)V_lds + v_rd_base(lane);
    const char* kvb = (const char*)(kv + krow0 * 1024 + h * 128);
    const char* kpb = (const char*)(kpe + krow0 * 32);
    const unsigned koff = (unsigned)(skey * 1024 + sc) * 2u, poff = (unsigned)(pkey * 32 + pc) * 2u;
    struct { bf16x8 v, k, p; } sr_[2];
#define SLOAD(i, k0) do { const char* kb_ = kvb + (size_t)(k0) * 2048; sr_[i].v = *reinterpret_cast<const bf16x8*>(kb_ + 128 + koff); sr_[i].k = *reinterpret_cast<const bf16x8*>(kb_ + koff); \
    sr_[i].p = *reinterpret_cast<const bf16x8*>(kpb + (size_t)(k0) * 64 + poff); } while (0)
#define SWRITE(bb, i) do { *(bf16x8*)(V_lds + (bb) * SHM_V + vst) = sr_[i].v; *(bf16x8*)(K_lds + (bb) * SHM_K + kst) = sr_[i].k; \
    if (tid < 256) *(bf16x8*)(K_lds + (bb) * SHM_K + pst) = sr_[i].p; } while (0)
#define SWAIT() asm volatile("s_waitcnt vmcnt(3)" ::: "memory")
#define RESC(a) do { if (__any((a) < 1.f)) { if (hi == 0) al_l[r32] = (a); asm volatile("s_waitcnt lgkmcnt(0)" ::: "memory"); \
    _Pragma("unroll") for (int d = 0; d < 2; ++d) _Pragma("unroll") for (int r = 0; r < 16; ++r) o[d][r] *= al_l[crow(r, hi)]; } } while (0)
    f32x16 pA0, pA1, pB0, pB1; float mnA, mnB, alA, alB; bf16x8 pa0, pa1, pa2, pa3;
    const int NT = 4 * qb + 4, tmax = 4 * qb + (wid >> 1);
    constexpr int SE = 0, SO = 1;
    SLOAD(SE, 0); asm volatile("s_waitcnt vmcnt(0)" ::: "memory"); SWRITE(0, SE); __syncthreads();
    qkt(pA0, pA1, K_lds, qr, r32, hi, false); partialSM(pA0, pA1, m_reg, mnA, alA);
    SLOAD(SO, KVBLK); if (2 < NT) SLOAD(SE, 2 * KVBLK);
    SWAIT(); SWRITE(1, SO); __syncthreads();
    for (int j = 1; j + 1 < NT; j += 2) {
        SBAR(); qkt(pB0, pB1, K_lds + SHM_K, qr, r32, hi, j > tmax);
        finishSM(pA0, pA1, alA, l_reg, pa0, pa1, pa2, pa3); SBAR();
        SLOAD(SO, (j + 2) * KVBLK); SBAR();
        pv_d0(o, vb0, pa0, pa1, pa2, pa3); partialSM(pB0, pB1, m_reg, mnB, alB);
        __syncthreads(); SWAIT(); SWRITE(0, SE);
        RESC(alB); __syncthreads();
        SBAR(); qkt(pA0, pA1, K_lds, qr, r32, hi, (j + 1) > tmax);
        finishSM(pB0, pB1, alB, l_reg, pa0, pa1, pa2, pa3); SBAR();
        if (j + 3 < NT) SLOAD(SE, (j + 3) * KVBLK); SBAR();
        pv_d0(o, vb0 + SHM_V, pa0, pa1, pa2, pa3); partialSM(pA0, pA1, m_reg, mnA, alA);
        __syncthreads(); SWAIT(); SWRITE(1, SO);
        RESC(alA); __syncthreads();
    }
    SBAR(); qkt(pB0, pB1, K_lds + SHM_K, qr, r32, hi, (NT - 1) > tmax);
    finishSM(pA0, pA1, alA, l_reg, pa0, pa1, pa2, pa3); SBAR();
    pv_d0(o, vb0, pa0, pa1, pa2, pa3); partialSM(pB0, pB1, m_reg, mnB, alB);
    __syncthreads(); RESC(alB);
    finishSM(pB0, pB1, alB, l_reg, pa0, pa1, pa2, pa3); SBAR();
    pv_d0(o, vb0 + SHM_V, pa0, pa1, pa2, pa3);
    if (hi == 0) li_l[r32] = l_reg; asm volatile("s_waitcnt lgkmcnt(0)" ::: "memory");
    float rli[16];
#pragma unroll
    for (int r = 0; r < 16; ++r) rli[r] = __builtin_amdgcn_rcpf(li_l[crow(r, hi)]);
    bf16_t* Ow = y + (row0 + wid * QBLK) * 1024 + 512 + h * 64;
#pragma unroll
    for (int r = 0; r < 16; ++r) { const int orow = crow(r, hi); const float a = o[0][r] * rli[r], c = o[1][r] * rli[r];
        Ow[(size_t)orow * 1024 + r32] = (bf16_t)f2bf(a); Ow[(size_t)orow * 1024 + 32 + r32] = (bf16_t)f2bf(c);
        float s = a * a + c * c;
        s += __shfl_xor(s, 1); s += __shfl_xor(s, 2); s += __shfl_xor(s, 4); s += __shfl_xor(s, 8); s += __shfl_xor(s, 16);
        if (r32 == 0) ss_add(ssm + row0 + wid * QBLK + orow, s); }
    __syncthreads();
#undef SLOAD
#undef SWRITE
#undef SWAIT
#undef RESC
}
#undef KSWZ
#undef SBAR
}

namespace ssm {
__device__ __forceinline__ int crow(int r, int hi) { return (r & 3) + 8 * (r >> 2) + 4 * hi; }
__device__ __forceinline__ unsigned cvtpk_s(float lo, float hi) { typedef __bf16 bf16x2_t __attribute__((ext_vector_type(2))); f32x2 v = {lo, hi}; bf16x2_t b = __builtin_convertvector(v, bf16x2_t); return __builtin_bit_cast(unsigned, b); }
template <bool FINAL>
__device__ __forceinline__ void item(int it, const bf16_t* z, const f32x2* abar, const f32x2* a128, const bf16_t* BBT, const bf16_t* CCT, const float* dskip,
                                     float* Sc, bf16_t* yg, LAS bf16_t* xl, int lane) {
    const int cp = it & 15, g = (it >> 4) & 31, b = it >> 9, r32 = lane & 31, hi = lane >> 5;
    const int sub = (r32 >> 2) & 1, i16 = (r32 & 3) + 4 * (r32 >> 3);
    const size_t tA = (size_t)b * SEQ + (size_t)(2 * cp + sub) * 128 + i16;
    bf16x8 bb[4];
#pragma unroll
    for (int nb = 0; nb < 4; ++nb) bb[nb] = *(const bf16x8*)(BBT + ((size_t)(g * 128 + nb * 32 + r32) * 16 + hi * 8));
    const f32x2 a0 = abar[g * 64 + r32], a1 = abar[g * 64 + 32 + r32];
    float xr0 = 0.f, xi0 = 0.f, xr1 = 0.f, xi1 = 0.f;
    const int chunk = (b * 32 + g) * 32 + 2 * cp + hi;
    bf16x8 cc[8]; float dsk[8];
    if constexpr (FINAL) {
        const f32x2 A0 = a128[g * 64 + r32], A1 = a128[g * 64 + 32 + r32]; const int jn = 2 * cp + hi;
#pragma unroll 8
        for (int k = 0; k < 31; ++k) { const float* S = Sc + (size_t)((b * 32 + g) * 32 + k) * 128;
            const float s0r = S[r32], s0i = S[32 + r32], s1r = S[64 + r32], s1i = S[96 + r32];
            const float n0r = A0.x * xr0 - A0.y * xi0 + s0r, n0i = A0.x * xi0 + A0.y * xr0 + s0i, n1r = A1.x * xr1 - A1.y * xi1 + s1r, n1i = A1.x * xi1 + A1.y * xr1 + s1i;
            const bool on = k < jn; xr0 = on ? n0r : xr0; xi0 = on ? n0i : xi0; xr1 = on ? n1r : xr1; xi1 = on ? n1i : xi1; }
#pragma unroll
        for (int s = 0; s < 8; ++s) cc[s] = *(const bf16x8*)(CCT + ((size_t)(g * 32 + r32) * 128 + s * 16 + hi * 8));
#pragma unroll
        for (int j = 0; j < 8; ++j) dsk[j] = dskip[g * 16 + (lane & 1) * 8 + j];
    }
#pragma unroll 1
    for (int blk = 0; blk < 8; ++blk) {
        const bf16x8 u8 = *(const bf16x8*)(z + (tA + blk * 16) * ZP + g * 16 + hi * 8);
        f32x16 X[4];
#pragma unroll
        for (int nb = 0; nb < 4; ++nb) X[nb] = __builtin_amdgcn_mfma_f32_32x32x16_bf16(u8, bb[nb], f32x16{}, 0, 0, 0);
#pragma unroll
        for (int r = 0; r < 16; ++r) {
            const float n0r = a0.x * xr0 - a0.y * xi0 + X[0][r], n0i = a0.x * xi0 + a0.y * xr0 + X[1][r];
            const float n1r = a1.x * xr1 - a1.y * xi1 + X[2][r], n1i = a1.x * xi1 + a1.y * xr1 + X[3][r];
            xr0 = n0r; xi0 = n0i; xr1 = n1r; xi1 = n1i;
            if constexpr (FINAL) { X[0][r] = n0r; X[1][r] = n0i; X[2][r] = n1r; X[3][r] = n1i; } }
        if constexpr (FINAL) {
#pragma unroll
            for (int r = 0; r < 16; ++r) { u32x2 w; w.x = cvtpk_s(X[0][r], X[1][r]); w.y = cvtpk_s(X[2][r], X[3][r]);
                *(LAS u32x2*)(xl + crow(r, hi) * 136 + r32 * 4) = w; }
            asm volatile("s_waitcnt lgkmcnt(0)" ::: "memory");
            f32x16 yv = f32x16{};
#pragma unroll
            for (int s = 0; s < 8; ++s) { const bf16x8 xa = *(const LAS bf16x8*)(xl + r32 * 136 + s * 16 + hi * 8); yv = __builtin_amdgcn_mfma_f32_32x32x16_bf16(xa, cc[s], yv, 0, 0, 0); }
            asm volatile("s_waitcnt lgkmcnt(0)" ::: "memory");
            LAS float* yl = (LAS float*)(xl + 32 * 136);
            if (r32 < 16) {
#pragma unroll
                for (int r = 0; r < 16; ++r) yl[crow(r, hi) * 17 + r32] = yv[r]; }
            asm volatile("s_waitcnt lgkmcnt(0)" ::: "memory");
            { const int R = lane >> 1, hh = lane & 1; const int rs = (R >> 2) & 1, ri = (R & 3) + 4 * (R >> 3);
              const size_t tok = (size_t)b * SEQ + (size_t)(2 * cp + rs) * 128 + blk * 16 + ri;
              const u32x4 uw = *(const u32x4*)(z + tok * ZP + g * 16 + hh * 8);
              const float uu[8] = {bflo(uw.x), bfhi(uw.x), bflo(uw.y), bfhi(uw.y), bflo(uw.z), bfhi(uw.z), bflo(uw.w), bfhi(uw.w)};
              float ov[8];
#pragma unroll
              for (int j = 0; j < 8; ++j) ov[j] = gelu_tanh(yl[R * 17 + hh * 8 + j] + dsk[j] * uu[j]);
              u32x4 ow; ow.x = pk2(ov[0], ov[1]); ow.y = pk2(ov[2], ov[3]); ow.z = pk2(ov[4], ov[5]); ow.w = pk2(ov[6], ov[7]);
              *(u32x4*)(yg + tok * 512 + g * 16 + hh * 8) = ow; }
            asm volatile("s_waitcnt lgkmcnt(0)" ::: "memory");
        }
    }
    if constexpr (!FINAL) { float* S = Sc + (size_t)chunk * 128; S[r32] = xr0; S[32 + r32] = xi0; S[64 + r32] = xr1; S[96 + r32] = xi1; }
}
}

namespace moe {
using pg8::Unit;
struct Ctx { const LAS int* tmap; int ntile; const unsigned* cnt; const int* list; const int* listd; const float* listw; const float* rstd3; };
struct ProbGU {
    static constexpr bool GATHER = true;
    const bf16_t* A; const bf16_t* Bt; int ldb; Ctx X; int G, c;
    __device__ __forceinline__ bool next(int i, Unit& u) const { const int L = i * G + c; if (L >= X.ntile * 2) return false; u.pm = L >> 1; u.pn = L & 1; u.aux = X.tmap[u.pm]; return true; }
    __device__ __forceinline__ int nkt(const Unit&) const { return 16; }
    __device__ __forceinline__ const char* a_ptr(const Unit&) const { return (const char*)A; }
    __device__ __forceinline__ const char* b_ptr(const Unit& u) const { return (const char*)(Bt + ((size_t)(u.aux & 255) * 512 + u.pn * 256) * 1024); }
    __device__ __forceinline__ void a_off(const Unit& u, const int (&R)[2], const int (&C)[2], unsigned (&v)[2][2]) const {
        const int e = u.aux & 255, rt = u.aux >> 8; const int n = (int)X.cnt[e];
#pragma unroll
        for (int h = 0; h < 2; ++h)
#pragma unroll
            for (int i = 0; i < 2; ++i) { const int pos = rt * 256 + h * 128 + R[i]; const int tok = pos < n ? X.list[e * LCAP + pos] : 0; v[h][i] = (unsigned)(tok * 1024 + C[i]) * 2u; }
    }
};
struct EpiGU {
    static constexpr bool PERM = true, AFTER_DRAIN = false, MIDK = false;
    bf16_t* h1; Ctx X;
    __device__ __forceinline__ void operator()(const epi::Acc& acc, const Unit& u, int wr, int wc, int fr, int fq) const {
        const int e = u.aux & 255, rt = u.aux >> 8; const int n = (int)X.cnt[e];
#pragma unroll
        for (int ai = 0; ai < 2; ++ai)
#pragma unroll
            for (int m = 0; m < 4; ++m) { const int r = ai * 128 + wr * 64 + m * 16 + fr, pos = rt * 256 + r; const size_t srow = (size_t)u.pm * 256 + r;
                const int tok = pos < n ? X.list[e * LCAP + pos] : 0; const float rs = X.rstd3[tok];
                f32x4 o0, o1;
#pragma unroll
                for (int k = 0; k < 4; ++k) { const float g0 = acc[ai][0][m][0][k] * rs, u0 = acc[ai][1][m][0][k] * rs, g1 = acc[ai][0][m][1][k] * rs, u1 = acc[ai][1][m][1][k] * rs;
                    o0[k] = g0 * sigmoidf_(g0) * u0; o1[k] = g1 * sigmoidf_(g1) * u1; }
                *(u32x4*)(h1 + srow * 256 + u.pn * 128 + wc * 32 + 8 * fq) = epi::pack8(o0, o1); asm volatile("" ::: "memory"); }
    }
};
struct ProbD {
    static constexpr bool GATHER = false;
    const bf16_t* A; const bf16_t* Bt; int ldb; Ctx X; int G, c, nk;
    __device__ __forceinline__ bool next(int i, Unit& u) const { const int L = i * G + c; if (L >= X.ntile * 4) return false; u.pm = L >> 2; u.pn = L & 3; u.aux = X.tmap[u.pm]; return true; }
    __device__ __forceinline__ int nkt(const Unit&) const { return nk; }
    __device__ __forceinline__ const char* a_ptr(const Unit& u) const { return (const char*)(A + (size_t)u.pm * 256 * 256); }
    __device__ __forceinline__ const char* b_ptr(const Unit& u) const { return (const char*)(Bt + ((size_t)(u.aux & 255) * 1024 + u.pn * 256) * 256); }
    __device__ __forceinline__ void a_off(const Unit&, const int (&R)[2], const int (&C)[2], unsigned (&v)[2][2]) const {
#pragma unroll
        for (int i = 0; i < 2; ++i) { v[0][i] = (unsigned)(R[i] * 256 + C[i]) * 2u; v[1][i] = (unsigned)((R[i] + 128) * 256 + C[i]) * 2u; }
    }
};
struct EpiD {
    static constexpr bool PERM = true, AFTER_DRAIN = false, MIDK = false;
    bf16_t* ymoe; Ctx X;
    __device__ __forceinline__ void operator()(const epi::Acc& acc, const Unit& u, int wr, int wc, int fr, int fq) const {
        const int e = u.aux & 255, rt = u.aux >> 8; const int n = (int)X.cnt[e];
#pragma unroll
        for (int ai = 0; ai < 2; ++ai)
#pragma unroll
            for (int m = 0; m < 4; ++m) { const int r = ai * 128 + wr * 64 + m * 16 + fr, pos = rt * 256 + r;
                const bool ok = pos < n; const int li = ok ? e * LCAP + pos : 0; const int dst = ok ? X.listd[li] : 2 * T; const float w = ok ? X.listw[li] : 0.f;
#pragma unroll
                for (int bj = 0; bj < 2; ++bj) { const int col = u.pn * 256 + bj * 128 + wc * 32 + 8 * fq;
                    *(u32x4*)(ymoe + (size_t)dst * 1024 + col) = epi::pack8(acc[ai][bj][m][0] * w, acc[ai][bj][m][1] * w); }
                asm volatile("" ::: "memory"); }
    }
};
}

typedef GAS unsigned gu32;
#define RLX_AGENT __ATOMIC_RELAXED, __HIP_MEMORY_SCOPE_AGENT
#define XB_TMO      128
#define XB_XCNT(j)  (256  + 64 * (j))
#define XB_XSUB(j)  (1280 + 64 * (j))
#define XB_XGEN(j)  (2304 + 64 * (j))
#define XB_TOP      3328
#define XB_TOPGEN   3392
#define XCD_BAR_WORDS 3456
#define XB_SPIN_CAP (1u << 18)
__device__ __forceinline__ unsigned xb_ld(unsigned* p)              { return __hip_atomic_load(p, __ATOMIC_RELAXED, __HIP_MEMORY_SCOPE_AGENT); }
__device__ __forceinline__ unsigned xb_add(unsigned* p, unsigned v) { return __hip_atomic_fetch_add(p, v, __ATOMIC_RELAXED, __HIP_MEMORY_SCOPE_AGENT); }
__device__ __forceinline__ unsigned xb_xcc_id() { return (unsigned)__builtin_amdgcn_s_getreg((3 << 11) | 20) & 0xFu; }
#define XB_SPIN(cond, bar) do { unsigned _sp = 0; while (cond) { __builtin_amdgcn_s_sleep(1); \
    if ((++_sp & 255u) == 0u) { if (xb_ld(&(bar)[XB_TMO])) break; if (_sp > XB_SPIN_CAP) { atomicAdd(&(bar)[XB_TMO], 1u); break; } } } } while (0)
struct XcdBarrier { unsigned* bar; unsigned x; volatile LAS unsigned* st; };
__device__ __forceinline__ XcdBarrier xcd_barrier_post(unsigned* bar, volatile LAS unsigned* st) {
    XcdBarrier b; b.bar = bar; b.x = xb_xcc_id(); b.st = st;
    if (threadIdx.x == 0) (void)xb_add(&bar[XB_XCNT(b.x)], 1u);
    return b;
}
__device__ __forceinline__ void xcd_barrier_complete(unsigned* bar, unsigned x, unsigned& nloc, unsigned& nx) {
    const unsigned G = gridDim.x * gridDim.y * gridDim.z;
    unsigned sum, cnt, mine, sp = 0u;
    for (;;) {
        sum = 0u; cnt = 0u; mine = 0u;
#pragma unroll
        for (unsigned j = 0; j < 16; ++j) { const unsigned c = xb_ld(&bar[XB_XCNT(j)]); sum += c; cnt += (c > 0u) ? 1u : 0u; mine = (j == x) ? c : mine; }
        if (sum == G) break;
        __builtin_amdgcn_s_sleep(1);
        if ((++sp & 255u) == 0u) { if (xb_ld(&bar[XB_TMO])) break; if (sp > XB_SPIN_CAP) { atomicAdd(&bar[XB_TMO], 1u); break; } }
    }
    nloc = mine > 0u ? mine : 1u; nx = cnt > 0u ? cnt : 1u;
}
__device__ __forceinline__ void xcd_barrier(const XcdBarrier& b) {
    asm volatile("s_waitcnt vmcnt(0)" ::: "memory");
    __syncthreads();
    if (threadIdx.x == 0) {
        unsigned* bar = b.bar;
        __builtin_amdgcn_s_waitcnt(0);
        unsigned nloc = b.st[0], nx = b.st[1];
        if (nloc == 0u) { xcd_barrier_complete(bar, b.x, nloc, nx); b.st[0] = nloc; b.st[1] = nx; }
        const unsigned old = xb_add(&bar[XB_XSUB(b.x)], 1u);
        const unsigned gen = old / nloc;
        if (old + 1u == (gen + 1u) * nloc) {
            __builtin_amdgcn_fence(__ATOMIC_RELEASE, "agent");
            asm volatile("s_waitcnt vmcnt(0)" ::: "memory");
            const unsigned og = xb_add(&bar[XB_TOP], 1u);
            const unsigned tg = og / nx;
            if (og + 1u == (tg + 1u) * nx) xb_add(&bar[XB_TOPGEN], 1u);
            else XB_SPIN(xb_ld(&bar[XB_TOPGEN]) == tg, bar);
            __builtin_amdgcn_fence(__ATOMIC_ACQUIRE, "agent");
            xb_add(&bar[XB_XGEN(b.x)], 1u);
            asm volatile("s_waitcnt vmcnt(0)" ::: "memory");
        } else {
            XB_SPIN(xb_ld(&bar[XB_XGEN(b.x)]) == gen, bar);
            __builtin_amdgcn_fence(__ATOMIC_ACQUIRE, "agent");
            asm volatile("s_waitcnt vmcnt(0)" ::: "memory");
        }
    }
    __syncthreads();
}
__device__ __forceinline__ void cu_sync_global() {
    asm volatile("s_waitcnt vmcnt(0)" ::: "memory");
    __syncthreads();
    if (threadIdx.x == 0) { __builtin_amdgcn_fence(__ATOMIC_ACQUIRE, "agent"); asm volatile("s_waitcnt vmcnt(0)" ::: "memory"); }
    __syncthreads();
}

constexpr int NWAVES = 8;
constexpr int RING_BYTES = 131072, LDSCTL_OFF = RING_BYTES, MISC_OFF = LDSCTL_OFF + 320, TMAP_OFF = LDSCTL_OFF + 1024, LDS_BYTES = 147456;
struct Args { const void* in[37]; float* out; unsigned char* ws; int ph_lo, ph_hi, dry, li; };
enum { I_X = 0, I_MEM, I_POS, I_GMIX, I_WIN, I_LRE, I_LIM, I_LDT, I_BRE, I_BIM, I_CRE, I_CIM, I_SD, I_WGLU, I_BGLU, I_GQ, I_WQUP, I_GKV, I_WKVUP, I_GSSM, I_GMLA, I_WOUT,
       I_GX, I_GMEM, I_XWQ, I_XWK, I_XWV, I_XWO, I_GMOE, I_WGRP, I_BGRP, I_WEXP, I_BEXP, I_WGATE, I_WUP, I_WDOWN, I_GFIN };

struct Frame {
    LAS unsigned char* lds; unsigned char* ws; float* out; const void* const* in;
    int tid, lane, wave, vcu, G;
    __device__ __forceinline__ const float* f(int i) const { return (const float*)in[i]; }
    __device__ __forceinline__ bf16_t* wt(size_t off) const { return (bf16_t*)(ws + WS_WT) + off; }
    __device__ __forceinline__ ss_t* ctlf(int w) const { return (ss_t*)((unsigned*)(ws + WS_CTL) + w); }
};

__device__ __forceinline__ void tr_item(const float* W, int N, bf16_t* WT, int ldk, int k0, int n0, int drow0, const float* g0, const float* g1, LAS float* scr, int lane) {
    float wv[32];
#pragma unroll
    for (int i = 0; i < 32; ++i) { const int k = k0 + 2 * i + (lane >> 5); wv[i] = W[(size_t)k * N + n0 + (lane & 31)]; }
#pragma unroll
    for (int i = 0; i < 32; ++i) { const int kk = 2 * i + (lane >> 5), k = k0 + kk; float gn = 1.f; if (g0) gn = (g1 && k >= 512) ? g1[k - 512] : g0[k];
        scr[kk * 33 + (lane & 31)] = wv[i] * gn; }
    asm volatile("s_waitcnt lgkmcnt(0)" ::: "memory");
    const int c = lane & 7;
#pragma unroll
    for (int j = 0; j < 4; ++j) { const int n = (lane >> 3) + 8 * j; const LAS float* s = scr + (8 * c) * 33 + n;
        u32x4 o; o.x = pk2(s[0 * 33], s[1 * 33]); o.y = pk2(s[2 * 33], s[3 * 33]); o.z = pk2(s[4 * 33], s[5 * 33]); o.w = pk2(s[6 * 33], s[7 * 33]);
        *(u32x4*)(WT + (size_t)(drow0 + n) * ldk + k0 + 8 * c) = o; }
    asm volatile("s_waitcnt lgkmcnt(0)" ::: "memory");
}
__device__ __forceinline__ void rms_row_to_bf16(const float* xrow, const float* gain, bf16_t* orow, int lane) {
    const f32x4* xr = (const f32x4*)xrow + lane; const f32x4* gr = (const f32x4*)gain + lane;
    f32x4 v[4]; float s = 0.f;
#pragma unroll
    for (int j = 0; j < 4; ++j) { v[j] = xr[64 * j]; s += (v[j].x * v[j].x + v[j].y * v[j].y) + (v[j].z * v[j].z + v[j].w * v[j].w); }
    const float rstd = 1.f / sqrtf(wave_sum(s) * (1.f / 1024.f) + EPS);
    unsigned long long* o8 = (unsigned long long*)orow + lane;
#pragma unroll
    for (int j = 0; j < 4; ++j) { const f32x4 g = gr[64 * j]; o8[64 * j] = (unsigned long long)pk2(v[j].x * rstd * g.x, v[j].y * rstd * g.y) | ((unsigned long long)pk2(v[j].z * rstd * g.z, v[j].w * rstd * g.w) << 32); }
}
__device__ __forceinline__ void p0_prologue(Frame& F) {
    LAS float* scr = (LAS float*)(F.lds + F.wave * 16384);
    const int gw = F.vcu * NWAVES + F.wave, NGW = F.G * NWAVES, lane = F.lane;
    constexpr int N_IN = 16 * 49, N_QUP = 12 * 24, N_KVUP = 4 * 32, N_GLU = 8 * 16, N_SQ = 16 * 32, N_GU1 = 16 * 8, N_D1 = 4 * 32;
    constexpr int NITEMS = N_IN + N_QUP + N_KVUP + N_GLU + 5 * N_SQ;
    for (int it = gw; it < NITEMS; it += NGW) {
        int r = it;
        if (r < N_IN) { tr_item(F.f(I_WIN), DIN, F.wt(WT_IN), 1024, 64 * (r / 49), 32 * (r % 49), 32 * (r % 49), nullptr, nullptr, scr, lane); continue; } r -= N_IN;
        if (r < N_QUP) { tr_item(F.f(I_WQUP), 768, F.wt(WT_QUP), 768, 64 * (r / 24), 32 * (r % 24), 32 * (r % 24), F.f(I_GQ), nullptr, scr, lane); continue; } r -= N_QUP;
        if (r < N_KVUP) { tr_item(F.f(I_WKVUP), 1024, F.wt(WT_KVUP), 256, 64 * (r / 32), 32 * (r % 32), 32 * (r % 32), F.f(I_GKV), nullptr, scr, lane); continue; } r -= N_KVUP;
        if (r < N_GLU) { tr_item(F.f(I_WGLU), 512, F.wt(WT_GLU), 512, 64 * (r / 16), 32 * (r % 16), 32 * (r % 16), nullptr, nullptr, scr, lane); continue; } r -= N_GLU;
        if (r < 5 * N_SQ) { const int w = r / N_SQ, q = r % N_SQ; const int k0 = 64 * (q / 32), n0 = 32 * (q % 32);
            if (w == 0) tr_item(F.f(I_WOUT), 1024, F.wt(WT_OUT), 1024, k0, n0, n0, F.f(I_GSSM), F.f(I_GMLA), scr, lane);
            else if (w == 1) tr_item(F.f(I_XWQ), 1024, F.wt(WT_XQ), 1024, k0, n0, n0, F.f(I_GX), nullptr, scr, lane);
            else if (w == 2) tr_item(F.f(I_XWK), 1024, F.wt(WT_XK), 1024, k0, n0, n0, nullptr, nullptr, scr, lane);
            else if (w == 3) tr_item(F.f(I_XWV), 1024, F.wt(WT_XV), 1024, k0, n0, n0, nullptr, nullptr, scr, lane);
            else tr_item(F.f(I_XWO), 1024, F.wt(WT_XO), 1024, k0, n0, n0, nullptr, nullptr, scr, lane);
            continue; }
    }
    { u32x4* p = (u32x4*)(F.wt(WT_IN) + (size_t)DIN * 1024); const int n16 = (ZP - DIN) * 1024 * 2 / 16; const int gt = gw * 64 + lane;
        for (int i = gt; i < n16; i += NGW * 64) p[i] = (u32x4){0u, 0u, 0u, 0u}; }
    bf16_t* XN = (bf16_t*)(F.ws + WS_A); bf16_t* MEMN = (bf16_t*)(F.ws + WS_MEMN);
    for (int m = gw; m < T + 1024; m += NGW) {
        if (m < T) rms_row_to_bf16(F.f(I_X) + (size_t)m * 1024, F.f(I_GMIX), XN + (size_t)m * 1024, lane);
        else rms_row_to_bf16(F.f(I_MEM) + (size_t)(m - T) * 1024, F.f(I_GMEM), MEMN + (size_t)(m - T) * 1024, lane);
    }
    { f32x2* rope = (f32x2*)(F.ws + WS_ROPE); const int* pos = (const int*)F.in[I_POS]; const int gt = gw * 64 + lane;
        for (int i = gt; i < T * 16; i += NGW * 64) { const int t = i >> 4, k = i & 15;
            const float inv = powf(10000.f, -(float)k / 16.f); const float ang = (float)pos[t] * inv;
            rope[i] = (f32x2){(float)cos((double)ang), (float)sin((double)ang)}; } }
    { unsigned char* tab = F.ws + WS_TAB; f32x2* abar = (f32x2*)(tab + TAB_ABAR); f32x2* a256 = (f32x2*)(tab + TAB_A256);
        bf16_t* BBT = (bf16_t*)(tab + TAB_BBT); bf16_t* CCT = (bf16_t*)(tab + TAB_CCT); bf16_t* WRH = (bf16_t*)(tab + TAB_WRH); bf16_t* WRL = (bf16_t*)(tab + TAB_WRL);
        const int gt = gw * 64 + lane;
        if (gt < 2048) { const int g = gt >> 6, p = gt & 63;
            const double lre = fmin((double)F.f(I_LRE)[gt], -1e-4), lim = (double)F.f(I_LIM)[gt], dt = exp((double)F.f(I_LDT)[g]);
            const double zr = lre * dt, zi = lim * dt; const double er = exp(zr); const double ar = er * cos(zi), ai = er * sin(zi);
            abar[gt] = (f32x2){(float)ar, (float)ai};
            const double e2 = exp(128.0 * zr); a256[gt] = (f32x2){(float)(e2 * cos(128.0 * zi)), (float)(e2 * sin(128.0 * zi))};
            const double den = lre * lre + lim * lim; const double cr = ((ar - 1.0) * lre + ai * lim) / den, ci = (ai * lre - (ar - 1.0) * lim) / den;
            const int blk = 2 * (p >> 5), j = p & 31;
            for (int h = 0; h < 16; ++h) { const double br = (double)F.f(I_BRE)[(size_t)gt * 16 + h], bi = (double)F.f(I_BIM)[(size_t)gt * 16 + h];
                BBT[(size_t)(g * 128 + blk * 32 + j) * 16 + h] = (bf16_t)f2bf((float)(cr * br - ci * bi));
                BBT[(size_t)(g * 128 + (blk + 1) * 32 + j) * 16 + h] = (bf16_t)f2bf((float)(cr * bi + ci * br)); }
            for (int h = 0; h < 32; ++h) { float vr = 0.f, vi = 0.f;
                if (h < 16) { vr = F.f(I_CRE)[(size_t)(g * 16 + h) * 64 + p]; vi = -F.f(I_CIM)[(size_t)(g * 16 + h) * 64 + p]; }
                CCT[(size_t)(g * 32 + h) * 128 + j * 4 + blk] = (bf16_t)f2bf(vr); CCT[(size_t)(g * 32 + h) * 128 + j * 4 + blk + 1] = (bf16_t)f2bf(vi); } }
        for (int i = gt; i < 64 * 1024; i += NGW * 64) { const int n = i >> 10, k = i & 1023; float w = 0.f;
            if (n < 4) w = F.f(I_WGRP)[(size_t)k * 4 + n]; else if (n < 36) w = F.f(I_WEXP)[(size_t)k * 32 + (n - 4)];
            const unsigned hb = f2bf(w); WRH[i] = (bf16_t)hb; WRL[i] = (bf16_t)f2bf(w - bf2f((unsigned short)hb)); } }
}

constexpr int MOE_ITEMS = 64 * 128 + 32 * 128;
__device__ __forceinline__ void moe_convert(Frame& F, int first, int count, int widx, int nw) {
    LAS float* scr = (LAS float*)(F.lds + F.wave * 16384);
    for (int it = first + widx; it < first + count; it += nw) {
        int r = it;
        if (r < 64 * 128) { const int mi = r / 128, q = r % 128, e = mi >> 1, up = mi & 1; const int k0 = 64 * (q / 8), n0 = 32 * (q % 8);
            const float* W = F.f(up ? I_WUP : I_WGATE) + (size_t)e * 1024 * 256;
            tr_item(W, 256, F.wt(WT_GU) + (size_t)e * 512 * 1024, 1024, k0, n0, (n0 >> 7) * 256 + up * 128 + (n0 & 127), nullptr, nullptr, scr, F.lane); continue; } r -= 64 * 128;
        { const int e = r / 128, q = r % 128; const int k0 = 64 * (q / 32), n0 = 32 * (q % 32);
            tr_item(F.f(I_WDOWN) + (size_t)e * 256 * 1024, 1024, F.wt(WT_D) + (size_t)e * 1024 * 256, 256, k0, n0, n0, nullptr, nullptr, scr, F.lane); }
    }
}

__device__ __forceinline__ void router_phase(Frame& F, unsigned* cnt, unsigned char* lbase) {
    const int lane = F.lane, w = F.wave, r32 = lane & 31, hi = lane >> 5;
    for (int tb = F.vcu * 64; tb < T; tb += F.G * 64) {
    const float* x2 = F.out; const float* g3 = F.f(I_GMOE);
    bf16_t* XN3 = (bf16_t*)(F.ws + WS_Z);
    const bf16_t* WRH = (const bf16_t*)(F.ws + WS_TAB + TAB_WRH); const bf16_t* WRL = (const bf16_t*)(F.ws + WS_TAB + TAB_WRL);
    LAS float* part = (LAS float*)F.lds;
    LAS float* ssp = (LAS float*)(F.lds + 81920);
    f32x16 acc[2][2]; acc[0][0] = f32x16{}; acc[0][1] = f32x16{}; acc[1][0] = f32x16{}; acc[1][1] = f32x16{};
    float ss0 = 0.f, ss1 = 0.f;
#pragma unroll 2
    for (int s = 0; s < 8; ++s) { const int k = w * 128 + s * 16 + hi * 8;
        const f32x4 ga = *(const f32x4*)(g3 + k), gb = *(const f32x4*)(g3 + k + 4);
        bf16x8 wh[2], wl[2];
#pragma unroll
        for (int nb = 0; nb < 2; ++nb) { wh[nb] = *(const bf16x8*)(WRH + (size_t)(nb * 32 + r32) * 1024 + k); wl[nb] = *(const bf16x8*)(WRL + (size_t)(nb * 32 + r32) * 1024 + k); }
#pragma unroll
        for (int tq = 0; tq < 2; ++tq) { const size_t tok = (size_t)tb + tq * 32 + r32;
            const f32x4 xa = *(const f32x4*)(x2 + tok * 1024 + k), xb = *(const f32x4*)(x2 + tok * 1024 + k + 4);
            const float sq = (xa[0] * xa[0] + xa[1] * xa[1]) + (xa[2] * xa[2] + xa[3] * xa[3]) + (xb[0] * xb[0] + xb[1] * xb[1]) + (xb[2] * xb[2] + xb[3] * xb[3]);
            if (tq == 0) ss0 += sq; else ss1 += sq;
            const f32x4 va = xa * ga, vb = xb * gb;
            u32x4 h; h.x = pk2(va[0], va[1]); h.y = pk2(va[2], va[3]); h.z = pk2(vb[0], vb[1]); h.w = pk2(vb[2], vb[3]);
            *(u32x4*)(XN3 + tok * 1024 + k) = h;
            u32x4 l; l.x = pk2(va[0] - bflo(h.x), va[1] - bfhi(h.x)); l.y = pk2(va[2] - bflo(h.y), va[3] - bfhi(h.y)); l.z = pk2(vb[0] - bflo(h.z), vb[1] - bfhi(h.z)); l.w = pk2(vb[2] - bflo(h.w), vb[3] - bfhi(h.w));
            const bf16x8 bh = __builtin_bit_cast(bf16x8, h), bl = __builtin_bit_cast(bf16x8, l);
#pragma unroll
            for (int nb = 0; nb < 2; ++nb) {
                acc[tq][nb] = __builtin_amdgcn_mfma_f32_32x32x16_bf16(wh[nb], bh, acc[tq][nb], 0, 0, 0);
                acc[tq][nb] = __builtin_amdgcn_mfma_f32_32x32x16_bf16(wh[nb], bl, acc[tq][nb], 0, 0, 0);
                acc[tq][nb] = __builtin_amdgcn_mfma_f32_32x32x16_bf16(wl[nb], bh, acc[tq][nb], 0, 0, 0); } } }
#pragma unroll
    for (int tq = 0; tq < 2; ++tq) {
#pragma unroll
        for (int r = 0; r < 16; ++r) { const int n = (r & 3) + 8 * (r >> 2) + 4 * hi; part[(w * 64 + tq * 32 + r32) * 40 + n] = acc[tq][0][r]; }
        if (hi == 0) {
#pragma unroll
            for (int r = 0; r < 4; ++r) part[(w * 64 + tq * 32 + r32) * 40 + 32 + r] = acc[tq][1][r]; }
    }
    ss0 += __shfl_xor(ss0, 32); ss1 += __shfl_xor(ss1, 32);
    if (hi == 0) { ssp[w * 64 + r32] = ss0; ssp[w * 64 + 32 + r32] = ss1; }
    asm volatile("s_waitcnt lgkmcnt(0)" ::: "memory");
    __syncthreads();
    if (w == 0) {
        const int tok = tb + lane;
        float ss = 0.f;
#pragma unroll
        for (int k = 0; k < 8; ++k) ss += ssp[k * 64 + lane];
        const float rstd = 1.f / sqrtf(ss * (1.f / 1024.f) + EPS);
        float gl[4];
#pragma unroll
        for (int n = 0; n < 4; ++n) { float a = 0.f;
#pragma unroll
            for (int k = 0; k < 8; ++k) a += part[(k * 64 + lane) * 40 + n];
            gl[n] = a * rstd + F.f(I_BGRP)[n]; }
        int gi = 0; float gm = gl[0];
#pragma unroll
        for (int n = 1; n < 4; ++n) if (gl[n] > gm) { gm = gl[n]; gi = n; }
        float gsum = 0.f;
#pragma unroll
        for (int n = 0; n < 4; ++n) gsum += __expf(gl[n] - gm);
        const float gw_ = 1.f / gsum;
        float el[8];
#pragma unroll
        for (int j = 0; j < 8; ++j) { float a = 0.f;
#pragma unroll
            for (int k = 0; k < 8; ++k) a += part[(k * 64 + lane) * 40 + 4 + gi * 8 + j];
            el[j] = a * rstd + F.f(I_BEXP)[gi * 8 + j]; }
        int i0 = 0; float v0 = el[0];
#pragma unroll
        for (int j = 1; j < 8; ++j) if (el[j] > v0) { v0 = el[j]; i0 = j; }
        int i1 = -1; float v1 = -3.0e38f;
#pragma unroll
        for (int j = 0; j < 8; ++j) if (j != i0 && el[j] > v1) { v1 = el[j]; i1 = j; }
        const float w0 = 1.f / (1.f + __expf(v1 - v0)), w1 = 1.f - w0;
        const int e0 = gi * 8 + i0, e1 = gi * 8 + i1;
        int pos0 = 0, pos1 = 0; unsigned mycount = 0u;
        const unsigned long long lt = (1ull << lane) - 1ull;
        for (int e = 0; e < NEXP; ++e) {
            const unsigned long long m0 = __ballot(e0 == e), m1 = __ballot(e1 == e);
            const int c0 = __popcll(m0), c1 = __popcll(m1);
            if (lane == e) mycount = (unsigned)(c0 + c1);
            if (e0 == e) pos0 = __popcll(m0 & lt);
            if (e1 == e) pos1 = c0 + __popcll(m1 & lt);
        }
        unsigned mybase = 0u; if (lane < NEXP && mycount) mybase = atomicAdd(cnt + lane, mycount);
        pos0 += (int)__shfl(mybase, e0); pos1 += (int)__shfl(mybase, e1);
        int* list = (int*)(lbase); int* listd = (int*)(lbase + (WS_LISTD - WS_LIST)); float* listw = (float*)(lbase + (WS_LISTW - WS_LIST));
        list[e0 * LCAP + pos0] = tok; listd[e0 * LCAP + pos0] = tok * 2; listw[e0 * LCAP + pos0] = w0 * gw_;
        list[e1 * LCAP + pos1] = tok; listd[e1 * LCAP + pos1] = tok * 2 + 1; listw[e1 * LCAP + pos1] = w1 * gw_;
        float* rstd3 = (float*)(F.ws + WS_TOKI); rstd3[tok] = rstd;
        int* tinfo = (int*)(F.ws + WS_TOKI + 65536); tinfo[tok * 4 + 0] = e0; tinfo[tok * 4 + 1] = e1; tinfo[tok * 4 + 2] = pos0; tinfo[tok * 4 + 3] = pos1;
        float* tokw = (float*)(F.ws + WS_TOKI + 65536 + 262144); tokw[tok * 2] = w0 * gw_; tokw[tok * 2 + 1] = w1 * gw_;
    }
    __syncthreads();
    }
}

__device__ __forceinline__ void final_phase(Frame& F, float* outp) {
    const int gw = F.vcu * NWAVES + F.wave, NGW = F.G * NWAVES, lane = F.lane;
    const bf16_t* ymoe = (const bf16_t*)(F.ws + WS_YMOE); const f32x4* gr = (const f32x4*)F.f(I_GFIN) + lane;
    for (int m = gw; m < T; m += NGW) {
        const f32x4* xr = (const f32x4*)(F.out + (size_t)m * 1024) + lane; f32x4* xo = (f32x4*)(outp + (size_t)m * 1024) + lane;
        const u32x2* y0 = (const u32x2*)(ymoe + (size_t)(2 * m) * 1024) + lane; const u32x2* y1 = (const u32x2*)(ymoe + (size_t)(2 * m + 1) * 1024) + lane;
        f32x4 v[4]; float s = 0.f;
#pragma unroll
        for (int j = 0; j < 4; ++j) { v[j] = xr[64 * j]; const u32x2 a = y0[64 * j], b = y1[64 * j];
            v[j].x += bflo(a.x) + bflo(b.x); v[j].y += bfhi(a.x) + bfhi(b.x); v[j].z += bflo(a.y) + bflo(b.y); v[j].w += bfhi(a.y) + bfhi(b.y);
            s += (v[j].x * v[j].x + v[j].y * v[j].y) + (v[j].z * v[j].z + v[j].w * v[j].w); }
        float rstd = 1.f / sqrtf(wave_sum(s) * (1.f / 1024.f) + EPS);
#if TIMING_PROBE
        { const unsigned long long* ts = (const unsigned long long*)(F.ws + WS_TOKI + 786432); rstd *= 1.f + (float)(ts[TS_B] - ts[TS_A]) * 0.01f / (float)TS_SCALE; }
#endif
#pragma unroll
        for (int j = 0; j < 4; ++j) xo[64 * j] = v[j] * rstd * gr[64 * j];
    }
}

#if DEBUG_HYBRID
namespace nv {
template <class E>
__global__ __launch_bounds__(256) void gemm(const bf16_t* A, int lda, const bf16_t* Bt, int ldb, int K, E e) {
    __shared__ float As[16][65], Bs[16][65];
    const int tx = threadIdx.x & 15, ty = threadIdx.x >> 4, m0 = blockIdx.y * 64, n0 = blockIdx.x * 64;
    float acc[4][4] = {};
    for (int k0 = 0; k0 < K; k0 += 16) {
        for (int i = 0; i < 4; ++i) { const int idx = threadIdx.x + 256 * i, r = idx >> 4, kk = idx & 15;
            As[kk][r] = bf2f(A[(size_t)(m0 + r) * lda + k0 + kk]); Bs[kk][r] = bf2f(Bt[(size_t)(n0 + r) * ldb + k0 + kk]); }
        __syncthreads();
        for (int kk = 0; kk < 16; ++kk) { float a[4], b[4];
            for (int i = 0; i < 4; ++i) { a[i] = As[kk][ty + 16 * i]; b[i] = Bs[kk][tx + 16 * i]; }
            for (int i = 0; i < 4; ++i) for (int j = 0; j < 4; ++j) acc[i][j] += a[i] * b[j]; }
        __syncthreads();
    }
    for (int i = 0; i < 4; ++i) e(m0 + ty + 16 * i, n0, tx, acc[i]);
}
struct EZ { bf16_t* z; ss_t* ssq; ss_t* sskv; bf16_t* kpe; const f32x2* rope;
    __device__ void operator()(int row, int n0, int tx, const float (&v)[4]) const {
        if (n0 < 1536) { float s = 0.f; for (int j = 0; j < 4; ++j) { z[(size_t)row * ZP + n0 + tx + 16 * j] = (bf16_t)f2bf(v[j]); s += v[j] * v[j]; }
            if (n0 >= 512 && n0 < 1280) ss_add(ssq + row, s); else if (n0 >= 1280) ss_add(sskv + row, s); }
        else if (n0 == 1536) { const f32x2 cs = rope[(size_t)row * 16 + tx];
            kpe[(size_t)row * 32 + tx] = (bf16_t)f2bf(v[0] * cs.x - v[1] * cs.y); kpe[(size_t)row * 32 + 16 + tx] = (bf16_t)f2bf(v[0] * cs.y + v[1] * cs.x); } } };
struct EStore { bf16_t* O; int ldc;
    __device__ void operator()(int row, int n0, int tx, const float (&v)[4]) const { for (int j = 0; j < 4; ++j) O[(size_t)row * ldc + n0 + tx + 16 * j] = (bf16_t)f2bf(v[j]); } };
struct EVXT { bf16_t* O;
    __device__ void operator()(int row, int n0, int tx, const float (&v)[4]) const { for (int j = 0; j < 4; ++j) { const int n = n0 + tx + 16 * j; O[(size_t)(n >> 8) * 262144 + (size_t)row * 256 + (n & 255)] = (bf16_t)f2bf(v[j]); } } };
struct EQ { bf16_t* q; const ss_t* ssq; const f32x2* rope;
    __device__ void operator()(int row, int n0, int tx, const float (&v)[4]) const {
        const float rs = 1.f / sqrtf(ss_get(ssq + row) * (1.f / 768.f) + EPS) * QS; float o[4];
        for (int j = 0; j < 4; ++j) o[j] = v[j] * rs;
        for (int hh = 0; hh < 2; ++hh) { const int g32 = n0 / 32 + hh; if (g32 % 3 == 2) { const f32x2 cs = rope[(size_t)row * 16 + tx]; const float a = o[2 * hh], b = o[2 * hh + 1];
            o[2 * hh] = a * cs.x - b * cs.y; o[2 * hh + 1] = a * cs.y + b * cs.x; } }
        for (int j = 0; j < 4; ++j) q[(size_t)row * 768 + n0 + tx + 16 * j] = (bf16_t)f2bf(o[j]); } };
struct EKV { bf16_t* kv; const ss_t* sskv;
    __device__ void operator()(int row, int n0, int tx, const float (&v)[4]) const { const float rs = 1.f / sqrtf(ss_get(sskv + row) * (1.f / 256.f) + EPS);
        for (int j = 0; j < 4; ++j) kv[(size_t)row * 1024 + n0 + tx + 16 * j] = (bf16_t)f2bf(v[j] * rs); } };
struct EGLU { const bf16_t* yg; const float* bias; bf16_t* y; ss_t* ss;
    __device__ void operator()(int row, int n0, int tx, const float (&v)[4]) const { float s = 0.f;
        for (int j = 0; j < 4; ++j) { const int c = n0 + tx + 16 * j; const float o = bf2f(yg[(size_t)row * 512 + c]) * sigmoidf_(v[j] + bias[c]); s += o * o; y[(size_t)row * 1024 + c] = (bf16_t)f2bf(o); }
        ss_add(ss + row, s); } };
struct EOutA { const float* base; float* out; const ss_t* ss;
    __device__ void operator()(int row, int n0, int tx, const float (&v)[4]) const { const float rs = 1.f / sqrtf(ss_get(ss + row) * (1.f / 512.f) + EPS);
        for (int j = 0; j < 4; ++j) { const size_t o = (size_t)row * 1024 + n0 + tx + 16 * j; out[o] = base[o] + v[j] * rs; } } };
struct EOutB { float* out; bf16_t* xb; const ss_t* ss; ss_t* ssx;
    __device__ void operator()(int row, int n0, int tx, const float (&v)[4]) const { const float rs = 1.f / sqrtf(ss_get(ss + row) * (1.f / 512.f) + EPS); float s = 0.f;
        for (int j = 0; j < 4; ++j) { const size_t o = (size_t)row * 1024 + n0 + tx + 16 * j; const float x1 = out[o] + v[j] * rs; out[o] = x1; xb[o] = (bf16_t)f2bf(x1); s += x1 * x1; }
        ss_add(ssx + row, s); } };
struct EXQ { bf16_t* O; const ss_t* ss;
    __device__ void operator()(int row, int n0, int tx, const float (&v)[4]) const { const float rs = 1.f / sqrtf(ss_get(ss + row) * (1.f / 1024.f) + EPS) * XS;
        for (int j = 0; j < 4; ++j) O[(size_t)row * 1024 + n0 + tx + 16 * j] = (bf16_t)f2bf(v[j] * rs); } };
struct EAdd { float* out;
    __device__ void operator()(int row, int n0, int tx, const float (&v)[4]) const { for (int j = 0; j < 4; ++j) out[(size_t)row * 1024 + n0 + tx + 16 * j] += v[j]; } };

__global__ __launch_bounds__(64) void ssm_a(const bf16_t* z, const unsigned char* tab, float* Sc) {
    const int it = blockIdx.x, lane = threadIdx.x, c = it & 31, g = (it >> 5) & 31, b = it >> 10, p = lane;
    const f32x2 a = ((const f32x2*)(tab + TAB_ABAR))[g * 64 + p]; const bf16_t* BBT = (const bf16_t*)(tab + TAB_BBT);
    const int blk = 2 * (p >> 5), j = p & 31; float br[16], bi[16];
    for (int h = 0; h < 16; ++h) { br[h] = bf2f(BBT[(size_t)(g * 128 + blk * 32 + j) * 16 + h]); bi[h] = bf2f(BBT[(size_t)(g * 128 + (blk + 1) * 32 + j) * 16 + h]); }
    float xr = 0.f, xi = 0.f;
    for (int t = 0; t < 128; ++t) { const bf16_t* u = z + ((size_t)b * SEQ + c * 128 + t) * ZP + g * 16; float sr = 0.f, si = 0.f;
        for (int h = 0; h < 16; ++h) { const float uu = bf2f(u[h]); sr += br[h] * uu; si += bi[h] * uu; }
        const float nr = a.x * xr - a.y * xi + sr, ni = a.x * xi + a.y * xr + si; xr = nr; xi = ni; }
    Sc[(size_t)it * 128 + blk * 32 + j] = xr; Sc[(size_t)it * 128 + (blk + 1) * 32 + j] = xi;
}
__global__ __launch_bounds__(64) void ssm_c(const bf16_t* z, const unsigned char* tab, const float* dskip, bf16_t* yg) {
    const int g = blockIdx.x & 31, b = blockIdx.x >> 5, p = threadIdx.x;
    const f32x2 a = ((const f32x2*)(tab + TAB_ABAR))[g * 64 + p]; const bf16_t* BBT = (const bf16_t*)(tab + TAB_BBT); const bf16_t* CCT = (const bf16_t*)(tab + TAB_CCT);
    const int blk = 2 * (p >> 5), j = p & 31; float br[16], bi[16], cr[16], ci[16];
    for (int h = 0; h < 16; ++h) { br[h] = bf2f(BBT[(size_t)(g * 128 + blk * 32 + j) * 16 + h]); bi[h] = bf2f(BBT[(size_t)(g * 128 + (blk + 1) * 32 + j) * 16 + h]);
        cr[h] = bf2f(CCT[(size_t)(g * 32 + h) * 128 + j * 4 + blk]); ci[h] = bf2f(CCT[(size_t)(g * 32 + h) * 128 + j * 4 + blk + 1]); }
    float xr = 0.f, xi = 0.f;
    for (int t = 0; t < SEQ; ++t) { const size_t tok = (size_t)b * SEQ + t; const bf16_t* u = z + tok * ZP + g * 16; float sr = 0.f, si = 0.f, uu[16];
        for (int h = 0; h < 16; ++h) { uu[h] = bf2f(u[h]); sr += br[h] * uu[h]; si += bi[h] * uu[h]; }
        const float nr = a.x * xr - a.y * xi + sr, ni = a.x * xi + a.y * xr + si; xr = nr; xi = ni;
        for (int h = 0; h < 16; ++h) { const float yv = wave_sum(cr[h] * xr + ci[h] * xi);
            if (p == h) yg[tok * 512 + g * 16 + h] = (bf16_t)f2bf(gelu_tanh(yv + dskip[g * 16 + h] * uu[h])); } }
}
__global__ __launch_bounds__(64) void mla_attn(const bf16_t* q, const bf16_t* kv, const bf16_t* kpe, bf16_t* y, ss_t* ssm) {
    __shared__ float Ks[64][97], Vs[64][65];
    const int qc = blockIdx.x & 63, h = (blockIdx.x >> 6) & 7, b = blockIdx.x >> 9, tq = threadIdx.x;
    const size_t row = (size_t)b * SEQ + qc * 64 + tq;
    float qv[96], o[64]; for (int d = 0; d < 96; ++d) qv[d] = bf2f(q[row * 768 + h * 96 + d]); for (int d = 0; d < 64; ++d) o[d] = 0.f;
    float m = -1e30f, l = 0.f;
    for (int kt = 0; kt <= qc; ++kt) {
        __syncthreads();
        for (int i = threadIdx.x; i < 64 * 96; i += 64) { const int k = i / 96, d = i % 96; const size_t kr = (size_t)b * SEQ + kt * 64 + k;
            Ks[k][d] = d < 64 ? bf2f(kv[kr * 1024 + h * 128 + d]) : bf2f(kpe[kr * 32 + d - 64]); }
        for (int i = threadIdx.x; i < 64 * 64; i += 64) { const int k = i / 64, d = i % 64; Vs[k][d] = bf2f(kv[((size_t)b * SEQ + kt * 64 + k) * 1024 + h * 128 + 64 + d]); }
        __syncthreads();
        for (int k = 0; k < 64; ++k) { float s = 0.f; for (int d = 0; d < 96; ++d) s += qv[d] * Ks[k][d];
            const float mn = fmaxf(m, s), al = exp2f(m - mn), pp = exp2f(s - mn); l = l * al + pp; for (int d = 0; d < 64; ++d) o[d] = o[d] * al + pp * Vs[k][d]; m = mn; }
    }
    float s2 = 0.f; for (int d = 0; d < 64; ++d) { const float v = o[d] / l; s2 += v * v; y[row * 1024 + 512 + h * 64 + d] = (bf16_t)f2bf(v); }
    ss_add(ssm + row, s2);
}
__global__ __launch_bounds__(256) void xattn(const bf16_t* QX, const bf16_t* KX, const bf16_t* VXT, bf16_t* OX) {
    __shared__ float qs[256], ps[256], red[256];
    const int tok = blockIdx.x >> 2, h = blockIdx.x & 3, b = tok / SEQ, t = threadIdx.x;
    qs[t] = bf2f(QX[(size_t)tok * 1024 + h * 256 + t]); __syncthreads();
    float s = 0.f; const bf16_t* kr = KX + (size_t)(b * 256 + t) * 1024 + h * 256; for (int d = 0; d < 256; ++d) s += qs[d] * bf2f(kr[d]);
    red[t] = s; __syncthreads(); for (int o = 128; o > 0; o >>= 1) { if (t < o) red[t] = fmaxf(red[t], red[t + o]); __syncthreads(); }
    const float mx = red[0]; __syncthreads();
    const float p = exp2f(s - mx); ps[t] = bf2f((unsigned short)f2bf(p)); red[t] = p; __syncthreads(); for (int o = 128; o > 0; o >>= 1) { if (t < o) red[t] += red[t + o]; __syncthreads(); }
    const float l = red[0];
    float acc = 0.f; const bf16_t* vr = VXT + (size_t)b * 262144 + (size_t)(h * 256 + t) * 256; for (int k = 0; k < 256; ++k) acc += ps[k] * bf2f(vr[k]);
    OX[(size_t)tok * 1024 + h * 256 + t] = (bf16_t)f2bf(acc / l);
}
__global__ __launch_bounds__(256) void router(const float* x2, const float* g3, const float* wg, const float* bg, const float* we, const float* be, unsigned char* ws) {
    __shared__ float red[256]; __shared__ float lg[36];
    const int tok = blockIdx.x, t = threadIdx.x; float xv[4], hv[4]; float s = 0.f;
    for (int i = 0; i < 4; ++i) { xv[i] = x2[(size_t)tok * 1024 + t + 256 * i]; s += xv[i] * xv[i]; hv[i] = xv[i] * g3[t + 256 * i]; }
    red[t] = s; __syncthreads(); for (int o = 128; o > 0; o >>= 1) { if (t < o) red[t] += red[t + o]; __syncthreads(); }
    const float rstd = 1.f / sqrtf(red[0] * (1.f / 1024.f) + EPS); __syncthreads();
    bf16_t* XN3 = (bf16_t*)(ws + WS_Z); for (int i = 0; i < 4; ++i) XN3[(size_t)tok * 1024 + t + 256 * i] = (bf16_t)f2bf(hv[i]);
    for (int n = 0; n < 36; ++n) { float a = 0.f; for (int i = 0; i < 4; ++i) { const int k = t + 256 * i; a += hv[i] * (n < 4 ? wg[(size_t)k * 4 + n] : we[(size_t)k * 32 + n - 4]); }
        red[t] = a; __syncthreads(); for (int o = 128; o > 0; o >>= 1) { if (t < o) red[t] += red[t + o]; __syncthreads(); } if (t == 0) lg[n] = red[0] * rstd; __syncthreads(); }
    if (t == 0) { float gl[4]; for (int n = 0; n < 4; ++n) gl[n] = lg[n] + bg[n]; int gi = 0; float gm = gl[0]; for (int n = 1; n < 4; ++n) if (gl[n] > gm) { gm = gl[n]; gi = n; }
        float gs = 0.f; for (int n = 0; n < 4; ++n) gs += expf(gl[n] - gm); const float gw = 1.f / gs;
        float el[8]; for (int j = 0; j < 8; ++j) el[j] = lg[4 + gi * 8 + j] + be[gi * 8 + j];
        int i0 = 0; float v0 = el[0]; for (int j = 1; j < 8; ++j) if (el[j] > v0) { v0 = el[j]; i0 = j; }
        int i1 = -1; float v1 = -3.0e38f; for (int j = 0; j < 8; ++j) if (j != i0 && el[j] > v1) { v1 = el[j]; i1 = j; }
        const float w0 = 1.f / (1.f + expf(v1 - v0)), w1 = 1.f - w0; const int e0 = gi * 8 + i0, e1 = gi * 8 + i1;
        unsigned* cnt = (unsigned*)(ws + WS_CTL) + CW_CNT; const int pos0 = (int)atomicAdd(cnt + e0, 1u), pos1 = (int)atomicAdd(cnt + e1, 1u);
        int* list = (int*)(ws + WS_LIST); int* listd = (int*)(ws + WS_LISTD); float* listw = (float*)(ws + WS_LISTW);
        list[e0 * LCAP + pos0] = tok; listd[e0 * LCAP + pos0] = tok * 2; listw[e0 * LCAP + pos0] = w0 * gw;
        list[e1 * LCAP + pos1] = tok; listd[e1 * LCAP + pos1] = tok * 2 + 1; listw[e1 * LCAP + pos1] = w1 * gw;
        ((float*)(ws + WS_TOKI))[tok] = rstd; int* ti = (int*)(ws + WS_TOKI + 65536); ti[tok * 4] = e0; ti[tok * 4 + 1] = e1; ti[tok * 4 + 2] = pos0; ti[tok * 4 + 3] = pos1;
        float* tw = (float*)(ws + WS_TOKI + 65536 + 262144); tw[tok * 2] = w0 * gw; tw[tok * 2 + 1] = w1 * gw; }
}
__global__ __launch_bounds__(256) void moe_slot(unsigned char* ws) {
    __shared__ float hs[1024], av[256];
    const int tok = blockIdx.x >> 1, k = blockIdx.x & 1, t = threadIdx.x;
    const int e = ((const int*)(ws + WS_TOKI + 65536))[tok * 4 + k]; const float w = ((const float*)(ws + WS_TOKI + 65536 + 262144))[tok * 2 + k]; const float rstd = ((const float*)(ws + WS_TOKI))[tok];
    const bf16_t* XN3 = (const bf16_t*)(ws + WS_Z); for (int i = 0; i < 4; ++i) hs[t + 256 * i] = bf2f(XN3[(size_t)tok * 1024 + t + 256 * i]); __syncthreads();
    const bf16_t* WG = (const bf16_t*)(ws + WS_WT) + WT_GU + (size_t)e * 512 * 1024; const bf16_t* WD = (const bf16_t*)(ws + WS_WT) + WT_D + (size_t)e * 1024 * 256;
    const bf16_t* gr = WG + (size_t)((t >> 7) * 256 + (t & 127)) * 1024; const bf16_t* ur = gr + (size_t)128 * 1024; float g = 0.f, u = 0.f;
    for (int d = 0; d < 1024; ++d) { g += hs[d] * bf2f(gr[d]); u += hs[d] * bf2f(ur[d]); }
    g *= rstd; u *= rstd; av[t] = bf2f((unsigned short)f2bf(g * sigmoidf_(g) * u)); __syncthreads();
    bf16_t* ymoe = (bf16_t*)(ws + WS_YMOE);
    for (int i = 0; i < 4; ++i) { const int d = t + 256 * i; const bf16_t* dr = WD + (size_t)d * 256; float a = 0.f; for (int f = 0; f < 256; ++f) a += av[f] * bf2f(dr[f]);
        ymoe[(size_t)(tok * 2 + k) * 1024 + d] = (bf16_t)f2bf(a * w); }
}
__global__ __launch_bounds__(256) void final_rows(float* out, const bf16_t* ymoe, const float* g) {
    __shared__ float red[256]; const int tok = blockIdx.x, t = threadIdx.x; float v[4]; float s = 0.f;
    for (int i = 0; i < 4; ++i) { const int c = t + 256 * i; v[i] = out[(size_t)tok * 1024 + c] + bf2f(ymoe[(size_t)(2 * tok) * 1024 + c]) + bf2f(ymoe[(size_t)(2 * tok + 1) * 1024 + c]); s += v[i] * v[i]; }
    red[t] = s; __syncthreads(); for (int o = 128; o > 0; o >>= 1) { if (t < o) red[t] += red[t + o]; __syncthreads(); }
    const float rstd = 1.f / sqrtf(red[0] * (1.f / 1024.f) + EPS);
    for (int i = 0; i < 4; ++i) { const int c = t + 256 * i; out[(size_t)tok * 1024 + c] = v[i] * rstd * g[c]; }
}
}
#endif

constexpr int NPHASE = 12;
__global__ void __launch_bounds__(NWAVES * 64, 2) mega_fwd(Args args) {
    extern __shared__ __attribute__((aligned(16))) unsigned char lds_raw[];
    Frame F;
    F.lds = (LAS unsigned char*)lds_raw; F.ws = args.ws; F.out = args.out; F.in = args.in;
    F.tid = threadIdx.x; F.lane = F.tid & 63; F.wave = __builtin_amdgcn_readfirstlane(F.tid >> 6);
    F.G = gridDim.x; { const int bx = blockIdx.x; F.vcu = (F.G % 8 == 0) ? (bx % 8) * (F.G / 8) + bx / 8 : bx; }
    volatile LAS unsigned* MISC = (volatile LAS unsigned*)(F.lds + MISC_OFF);
    for (int u = F.tid; u < (LDS_BYTES - LDSCTL_OFF) / 4; u += NWAVES * 64) ((LAS unsigned*)(F.lds + LDSCTL_OFF))[u] = 0u;
    __syncthreads();
    const int lo = args.ph_lo, hi = args.ph_hi;
    unsigned* ctl = (unsigned*)(F.ws + WS_CTL);
    XcdBarrier bar; bar.bar = ctl + CW_BAR + args.li * XCD_BAR_WORDS; bar.x = 0; bar.st = nullptr;
    if (hi - lo > 1) bar = xcd_barrier_post(ctl + CW_BAR + args.li * XCD_BAR_WORDS, MISC + 8);
#ifndef PHASE_ENABLE
#define PHASE_ENABLE 0xFFF
#endif
#define IN(k) (((PHASE_ENABLE >> (k)) & 1) && lo <= (k) && (k) < hi)
#ifndef TIMING_PROBE
#define TIMING_PROBE 0
#endif
#if TIMING_PROBE
#define STAMP(k) do { if (blockIdx.x == 0 && F.tid == 0) ((unsigned long long*)(F.ws + WS_TOKI + 786432))[(k)] = __builtin_amdgcn_s_memrealtime(); } while (0)
#else
#define STAMP(k) do {} while (0)
#endif
#define SEAM(k) do { if (IN(k) && IN((k) + 1)) xcd_barrier(bar); STAMP((k) + 1); } while (0)
    unsigned char* ws = F.ws; const int c = (int)blockIdx.x, G = F.G;
#define XN ((bf16_t*)(ws + WS_A))
#define Y ((bf16_t*)(ws + WS_A))
#define OX ((bf16_t*)(ws + WS_A))
#define Z ((bf16_t*)(ws + WS_Z))
#define X1B ((bf16_t*)(ws + WS_Z))
#define XN3 ((bf16_t*)(ws + WS_Z))
#define QX ((bf16_t*)(ws + WS_QX))
#define H1 ((bf16_t*)(ws + WS_QX))
#define Q ((bf16_t*)(ws + WS_Q))
#define PB ((bf16_t*)(ws + WS_PB))
#define KV ((bf16_t*)(ws + WS_KV))
#define KPE ((bf16_t*)(ws + WS_KPE))
#define YG ((bf16_t*)(ws + WS_YG))
#define YMOE ((bf16_t*)(ws + WS_YMOE))
#define MEMN ((bf16_t*)(ws + WS_MEMN))
#define KX ((bf16_t*)(ws + WS_KX))
#define VXT ((bf16_t*)(ws + WS_VXT))
#define ROPE ((const f32x2*)(ws + WS_ROPE))
#define SC ((float*)(ws + WS_SC))
#define ABAR ((const f32x2*)(ws + WS_TAB + TAB_ABAR))
#define A256 ((const f32x2*)(ws + WS_TAB + TAB_A256))
#define BBT ((const bf16_t*)(ws + WS_TAB + TAB_BBT))
#define CCT ((const bf16_t*)(ws + WS_TAB + TAB_CCT))
#define SSQ (F.ctlf(CW_SSQ))
#define SSKV (F.ctlf(CW_SSKV))
#define SSMLA (F.ctlf(CW_SSMLA))
#define SSSSM (F.ctlf(CW_SSSSM))
#define SSX1 (F.ctlf(CW_SSX1))
#define LROW ((float*)(ws + WS_TOKI + 524288))

#ifndef DUP_MASK
#define DUP_MASK 0
#endif
#define DUPLOOP(k)
#define DRY (args.dry != 0)
#define DRYBAR do {} while (0)
#define DUMMY (ws + 244 * MiB)
    STAMP(0);
    if (IN(0)) { DUPLOOP(0) { p0_prologue(F);
#if DEBUG_HYBRID
        __syncthreads(); moe_convert(F, 0, MOE_ITEMS, F.vcu * NWAVES + F.wave, G * NWAVES);
#endif
        DRYBAR; } SEAM(0); }

    if (IN(1)) { DUPLOOP(1) {
        { pg8::ProbDense P{XN, F.wt(WT_IN), 1024, 1024, 1024, {}}; P.O.init(T / 256, ZP / 256, G, c);
          epi::EpiZ E{Z, DRY ? (ss_t*)DUMMY : SSQ, DRY ? (ss_t*)DUMMY : SSKV, KPE, ROPE}; pg8::gemm_phase<epi::EpiZ, pg8::ProbDense, true>(F.lds, P, E); }
        const int c2 = (c + 64) % G;
        { pg8::ProbDense P{MEMN, F.wt(WT_XK), 1024, 1024, 1024, {}}; P.O.init(4, 4, G, c2);
          epi::EpiStore E{KX, 1024}; pg8::gemm_phase<epi::EpiStore, pg8::ProbDense, true>(F.lds, P, E); }
        { pg8::ProbDense P{F.wt(WT_XV), MEMN, 1024, 1024, 1024, {}}; P.O.init(4, 4, G, c2 - 16);
          epi::EpiVXT E{VXT}; pg8::gemm_phase<epi::EpiVXT, pg8::ProbDense, true>(F.lds, P, E); }
        if (!DEBUG_HYBRID && G == 256 && c >= 224) { __syncthreads(); moe_convert(F, 0, 2048, (c - 224) * NWAVES + F.wave, 32 * NWAVES); }
        DRYBAR; }
        SEAM(1);
    }

    if (IN(2)) { DUPLOOP(2) {
        if (args.dry != 3) for (int it = F.vcu * NWAVES + F.wave; it < 2048; it += G * NWAVES)
            ssm::item<false>(it, Z, ABAR, A256, BBT, CCT, F.f(I_SD), SC, YG, (LAS bf16_t*)(F.lds + F.wave * 16384), F.lane);
        __syncthreads();
        if (args.dry != 2) {
        { pg8::ProbDense P{Z + 1280, F.wt(WT_KVUP), ZP, 256, 256, {}}; P.O.init(T / 256, 4, G, c);
          epi::EpiKV E{KV, SSKV}; pg8::gemm_phase<epi::EpiKV, pg8::ProbDense, true>(F.lds, P, E); }
        { pg8::ProbDense P{Z + 512, F.wt(WT_QUP), ZP, 768, 768, {}}; P.O.init(T / 256, 3, G, c);
          epi::EpiQ E{Q, SSQ, ROPE}; pg8::gemm_phase<epi::EpiQ, pg8::ProbDense, true>(F.lds, P, E); }
        if (!DEBUG_HYBRID && G == 256 && c >= 192) { __syncthreads(); moe_convert(F, 2048, 3072, (c - 192) * NWAVES + F.wave, 64 * NWAVES); }
        }
        DRYBAR; }
        SEAM(2);
    }

    if (IN(3)) { DUPLOOP(3) {
#ifndef NO_SSMC
        if (args.dry != 3) for (int it = F.vcu * NWAVES + F.wave; it < 2048; it += G * NWAVES)
            ssm::item<true>(it, Z, ABAR, A256, BBT, CCT, F.f(I_SD), SC, YG, (LAS bf16_t*)(F.lds + F.wave * 16384), F.lane);
#endif
        __syncthreads();
#ifndef NO_MLA
        if (args.dry != 2) for (int v = F.vcu; v < 256; v += G) { const int bh = v >> 3, s = v & 7;
            mla::unit(bh >> 3, bh & 7, s, Q, KV, KPE, Y, DRY ? (ss_t*)DUMMY : SSMLA, (char*)lds_raw);
            mla::unit(bh >> 3, bh & 7, 15 - s, Q, KV, KPE, Y, DRY ? (ss_t*)DUMMY : SSMLA, (char*)lds_raw); }
#endif
        DRYBAR; }
        SEAM(3);
    }

    if (IN(4)) { DUPLOOP(4) {
        { pg8::ProbDense P{YG, F.wt(WT_GLU), 512, 512, 512, {}}; P.O.init(T / 256, 2, G, c);
          epi::EpiGLU E{YG, F.f(I_BGLU), Y, DRY ? (ss_t*)DUMMY : SSSSM}; pg8::gemm_phase<epi::EpiGLU, pg8::ProbDense, true>(F.lds, P, E); }
        if (!DEBUG_HYBRID && G == 256 && c >= 128) { __syncthreads(); moe_convert(F, 5120, MOE_ITEMS - 5120, (c - 128) * NWAVES + F.wave, 128 * NWAVES); }
        else if (!DEBUG_HYBRID && G != 256 && IN(4)) { __syncthreads(); moe_convert(F, 0, MOE_ITEMS, F.vcu * NWAVES + F.wave, G * NWAVES); }
        DRYBAR; }
        SEAM(4);
    }

    if (IN(5)) { DUPLOOP(5) {
        { pg8::ProbDense P{Y, F.wt(WT_OUT), 1024, 1024, 1024, {}}; P.O.init(T / 256, 4, G, c);
          epi::EpiOut E{F.f(I_X), F.out, X1B, SSSSM, SSMLA, DRY ? (ss_t*)DUMMY : SSX1}; pg8::gemm_phase<epi::EpiOut, pg8::ProbDense, true>(F.lds, P, E); }
        DRYBAR; }
        SEAM(5);
    }

    if (IN(6)) { DUPLOOP(6) {
        pg8::GridOrder O; O.init(T / 256, 4, G, c);
        int pm, h;
        for (int i = 0; O.get(i, pm, h); ++i) { const int b = pm / 16;
            { pg8::ProbOne P{X1B + (size_t)pm * 256 * 1024, F.wt(WT_XQ) + (size_t)h * 256 * 1024, 1024, 1024, 1024, pm, h};
              epi::EpiXQ E{QX, SSX1}; pg8::gemm_phase<epi::EpiXQ, pg8::ProbOne, false>(F.lds, P, E); }
            cu_sync_global();
            { pg8::ProbOne P{QX + (size_t)pm * 256 * 1024 + h * 256, KX + (size_t)b * 256 * 1024 + h * 256, 1024, 1024, 256, pm, h};
              epi::EpiSoft E{PB, LROW}; pg8::gemm_phase<epi::EpiSoft, pg8::ProbOne, false>(F.lds, P, E); }
            cu_sync_global();
            { pg8::ProbOne P{PB + (size_t)pm * 256 * 1024 + h * 256, VXT + (size_t)b * 262144 + (size_t)h * 256 * 256, 1024, 256, 256, pm, h};
              epi::EpiPV E{OX, LROW}; pg8::gemm_phase<epi::EpiPV, pg8::ProbOne, false>(F.lds, P, E); }
        }
        DRYBAR; }
        SEAM(6);
    }

    if (IN(7)) { DUPLOOP(7) {
        { pg8::ProbDense P{OX, F.wt(WT_XO), 1024, 1024, 1024, {}}; P.O.init(T / 256, 4, G, c);
          epi::EpiAdd E{F.out, DRY ? (float*)(ws + WS_QX) : F.out}; pg8::gemm_phase<epi::EpiAdd, pg8::ProbDense, true>(F.lds, P, E); }
        DRYBAR; }
        SEAM(7);
    }

    if (IN(8)) { DUPLOOP(8) { router_phase(F, (unsigned*)(ws + WS_CTL) + CW_CNT + (DRY ? 64 : 0), DRY ? DUMMY + MiB : ws + WS_LIST); DRYBAR; } SEAM(8); }

    if (IN(9) || IN(10)) {
        LAS int* tmap = (LAS int*)(F.lds + TMAP_OFF); volatile LAS int* nt_l = (volatile LAS int*)(F.lds + TMAP_OFF + 1024);
        const unsigned* cnt = (const unsigned*)(ws + WS_CTL) + CW_CNT;
        if (F.tid == 0) { int j = 0; for (int e = 0; e < NEXP; ++e) { const int n = (int)__hip_atomic_load(cnt + e, RLX_AGENT); const int nr = (n + 255) >> 8; for (int r = 0; r < nr && j < 192; ++r) tmap[j++] = e | (r << 8); } nt_l[0] = j; }
        __syncthreads();
        moe::Ctx X{tmap, (int)nt_l[0], cnt, (const int*)(ws + WS_LIST), (const int*)(ws + WS_LISTD), (const float*)(ws + WS_LISTW), (const float*)(ws + WS_TOKI)};
        if (IN(9)) { DUPLOOP(9) { moe::ProbGU P{XN3, F.wt(WT_GU), 1024, X, G, c}; moe::EpiGU E{H1, X}; pg8::gemm_phase<moe::EpiGU, moe::ProbGU, true>(F.lds, P, E); DRYBAR; } SEAM(9); }
        if (IN(10)) { int nk4 = 4; asm volatile("" : "+s"(nk4)); moe::ProbD P{H1, F.wt(WT_D), 256, X, G, c, nk4}; DUPLOOP(10) { moe::EpiD E{YMOE, X}; pg8::gemm_phase<moe::EpiD, moe::ProbD, true>(F.lds, P, E); DRYBAR; } SEAM(10); }
    }

    if (IN(11)) { DUPLOOP(11) { final_phase(F, DRY ? (float*)(ws + WS_A) : F.out); DRYBAR; } }
#undef IN
#undef XN
#undef Y
#undef OX
#undef Z
#undef X1B
#undef XN3
#undef QX
#undef H1
#undef Q
#undef PB
#undef KV
#undef KPE
#undef YG
#undef YMOE
#undef MEMN
#undef KX
#undef VXT
#undef ROPE
#undef SC
#undef ABAR
#undef A256
#undef BBT
#undef CCT
#undef SSQ
#undef SSKV
#undef SSMLA
#undef SSSSM
#undef SSX1
#undef LROW
#undef SEAM
}

#ifndef FASTMASK
#define FASTMASK 0xFFF
#endif
extern "C" void kernel_launch(void* const* d_in, const int* in_sizes, int n_in, void* d_out, int out_size, void* d_ws, size_t ws_size, hipStream_t stream) {
    static int grid = 0;
    if (grid == 0) {
        if (n_in != 37 || in_sizes[0] != T * DM || out_size != T * DM || ws_size < WS_END) { fprintf(stderr, "kernel_launch: unexpected shapes (n_in %d, in0 %d, out %d, ws %zu)\n", n_in, n_in > 0 ? in_sizes[0] : -1, out_size, ws_size); grid = -1; return; }
        int dev = 0, cus = 0, per_cu = 0;
        if (hipGetDevice(&dev) != hipSuccess || hipDeviceGetAttribute(&cus, hipDeviceAttributeMultiprocessorCount, dev) != hipSuccess) { grid = -1; return; }
        if (hipFuncSetAttribute((const void*)mega_fwd, hipFuncAttributeMaxDynamicSharedMemorySize, LDS_BYTES) != hipSuccess) { fprintf(stderr, "kernel_launch: hipFuncSetAttribute failed\n"); grid = -1; return; }
        if (hipOccupancyMaxActiveBlocksPerMultiprocessor(&per_cu, (const void*)mega_fwd, NWAVES * 64, LDS_BYTES) != hipSuccess || per_cu < 1) fprintf(stderr, "kernel_launch: occupancy query says %d\n", per_cu);
        (void)hipGetLastError();
        grid = cus;
    }
    if (grid < 0) return;
    (void)hipMemsetAsync((char*)d_ws + WS_CTL, 0, CTL_ZERO_BYTES, stream);
    Args a{};
    for (int i = 0; i < 37; ++i) a.in[i] = d_in[i];
    a.out = (float*)d_out; a.ws = (unsigned char*)d_ws;
#if DEBUG_HYBRID
    unsigned char* ws = (unsigned char*)d_ws; bf16_t* WT = (bf16_t*)(ws + WS_WT);
    bf16_t* XN = (bf16_t*)(ws + WS_A); bf16_t* Y = XN; bf16_t* OX = XN; bf16_t* Z = (bf16_t*)(ws + WS_Z); bf16_t* X1B = Z;
    bf16_t* QX = (bf16_t*)(ws + WS_QX); bf16_t* Q = (bf16_t*)(ws + WS_Q); bf16_t* KV = (bf16_t*)(ws + WS_KV); bf16_t* KPE = (bf16_t*)(ws + WS_KPE); bf16_t* YG = (bf16_t*)(ws + WS_YG);
    bf16_t* YMOE = (bf16_t*)(ws + WS_YMOE); bf16_t* MEMN = (bf16_t*)(ws + WS_MEMN); bf16_t* KX = (bf16_t*)(ws + WS_KX); bf16_t* VXT = (bf16_t*)(ws + WS_VXT);
    const f32x2* ROPE = (const f32x2*)(ws + WS_ROPE); float* SC = (float*)(ws + WS_SC); unsigned* ctlw = (unsigned*)(ws + WS_CTL);
    ss_t* SSQ = (ss_t*)(ctlw + CW_SSQ); ss_t* SSKV = (ss_t*)(ctlw + CW_SSKV); ss_t* SSMLA = (ss_t*)(ctlw + CW_SSMLA); ss_t* SSSSM = (ss_t*)(ctlw + CW_SSSSM); ss_t* SSX1 = (ss_t*)(ctlw + CW_SSX1);
    const float* const* fin = (const float* const*)d_in; float* out = (float*)d_out;
    for (int s = 0; s < NPHASE; ++s) {
        if (s == 0 || ((FASTMASK >> s) & 1)) { a.ph_lo = s; a.ph_hi = s + 1; hipLaunchKernelGGL(mega_fwd, dim3(grid), dim3(NWAVES * 64), LDS_BYTES, stream, a); continue; }
        switch (s) {
        case 1: hipLaunchKernelGGL(nv::gemm<nv::EZ>, dim3(25, 256), dim3(256), 0, stream, XN, 1024, WT + WT_IN, 1024, 1024, nv::EZ{Z, SSQ, SSKV, KPE, ROPE});
                hipLaunchKernelGGL(nv::gemm<nv::EStore>, dim3(16, 16), dim3(256), 0, stream, MEMN, 1024, WT + WT_XK, 1024, 1024, nv::EStore{KX, 1024});
                hipLaunchKernelGGL(nv::gemm<nv::EVXT>, dim3(16, 16), dim3(256), 0, stream, WT + WT_XV, 1024, MEMN, 1024, 1024, nv::EVXT{VXT}); break;
        case 2: hipLaunchKernelGGL(nv::ssm_a, dim3(4096), dim3(64), 0, stream, Z, ws + WS_TAB, SC);
                hipLaunchKernelGGL(nv::gemm<nv::EQ>, dim3(12, 256), dim3(256), 0, stream, Z + 512, ZP, WT + WT_QUP, 768, 768, nv::EQ{Q, SSQ, ROPE});
                hipLaunchKernelGGL(nv::gemm<nv::EKV>, dim3(16, 256), dim3(256), 0, stream, Z + 1280, ZP, WT + WT_KVUP, 256, 256, nv::EKV{KV, SSKV}); break;
        case 3: hipLaunchKernelGGL(nv::ssm_c, dim3(128), dim3(64), 0, stream, Z, ws + WS_TAB, fin[I_SD], YG);
                hipLaunchKernelGGL(nv::mla_attn, dim3(4 * 8 * 64), dim3(64), 0, stream, Q, KV, KPE, Y, SSMLA); break;
        case 4: hipLaunchKernelGGL(nv::gemm<nv::EGLU>, dim3(8, 256), dim3(256), 0, stream, YG, 512, WT + WT_GLU, 512, 512, nv::EGLU{YG, fin[I_BGLU], Y, SSSSM}); break;
        case 5: hipLaunchKernelGGL(nv::gemm<nv::EOutA>, dim3(16, 256), dim3(256), 0, stream, Y, 1024, WT + WT_OUT, 1024, 512, nv::EOutA{fin[I_X], out, SSSSM});
                hipLaunchKernelGGL(nv::gemm<nv::EOutB>, dim3(16, 256), dim3(256), 0, stream, Y + 512, 1024, WT + WT_OUT + 512, 1024, 512, nv::EOutB{out, X1B, SSMLA, SSX1}); break;
        case 6: hipLaunchKernelGGL(nv::gemm<nv::EXQ>, dim3(16, 256), dim3(256), 0, stream, X1B, 1024, WT + WT_XQ, 1024, 1024, nv::EXQ{QX, SSX1});
                hipLaunchKernelGGL(nv::xattn, dim3(T * 4), dim3(256), 0, stream, QX, KX, VXT, OX); break;
        case 7: hipLaunchKernelGGL(nv::gemm<nv::EAdd>, dim3(16, 256), dim3(256), 0, stream, OX, 1024, WT + WT_XO, 1024, 1024, nv::EAdd{out}); break;
        case 8: hipLaunchKernelGGL(nv::router, dim3(T), dim3(256), 0, stream, out, fin[I_GMOE], fin[I_WGRP], fin[I_BGRP], fin[I_WEXP], fin[I_BEXP], ws); break;
        case 9: hipLaunchKernelGGL(nv::moe_slot, dim3(T * 2), dim3(256), 0, stream, ws); break;
        case 10: break;
        case 11: hipLaunchKernelGGL(nv::final_rows, dim3(T), dim3(256), 0, stream, out, YMOE, fin[I_GFIN]); break;
        }
    }
#else
#ifdef DUP_PHASE
#ifndef DUP_SUB
#define DUP_SUB 1
#endif
    if (DUP_PHASE > 0) { a.ph_lo = 0; a.ph_hi = DUP_PHASE; a.dry = 0; a.li = 0; hipLaunchKernelGGL(mega_fwd, dim3(grid), dim3(NWAVES * 64), LDS_BYTES, stream, a); }
    a.ph_lo = DUP_PHASE; a.ph_hi = DUP_PHASE + 1; a.dry = DUP_SUB; a.li = 1; hipLaunchKernelGGL(mega_fwd, dim3(grid), dim3(NWAVES * 64), LDS_BYTES, stream, a);
    a.ph_lo = DUP_PHASE; a.ph_hi = NPHASE; a.dry = 0; a.li = 2; hipLaunchKernelGGL(mega_fwd, dim3(grid), dim3(NWAVES * 64), LDS_BYTES, stream, a);
#else
    a.ph_lo = 0; a.ph_hi = NPHASE;
    hipLaunchKernelGGL(mega_fwd, dim3(grid), dim3(NWAVES * 64), LDS_BYTES, stream, a);
#endif
#endif
    const hipError_t le = hipPeekAtLastError();
    if (le != hipSuccess) fprintf(stderr, "kernel_launch: launch failed: %s\n", hipGetErrorName(le));
}
```
